# Optimizing an MI355X kernel written in HIP

```python
import math
import jax, jax.numpy as jnp
from jax import lax
import numpy as np

D_MODEL = 2048
BATCH = 4
SEQ = 2048
DEPTH = 1

GRID_W = 64
HEAD_DIM = 128
MIX_WIDTH = D_MODEL
NA_WIDTH = MIX_WIDTH // 2
DA_WIDTH = MIX_WIDTH - NA_WIDTH
NA_HEADS = NA_WIDTH // HEAD_DIM
DA_HEADS = DA_WIDTH // HEAD_DIM
DA_QK_DIM = HEAD_DIM // 2
NA_WIN_ROWS_MAX = 8
NA_WIN_COLS = 16
T5_BUCKETS = 32
T5_MAX_DIST = 128
D_FF = -(-8 * D_MODEL // (3 * 256)) * 256
Q_BLOCK = 128
EPS = 1e-6
PROJ_WIDTH = 3 * NA_WIDTH + 2 * DA_HEADS * 2 * DA_QK_DIM + DA_WIDTH

kernel_name = "hybrid_na_diffattn_adaln_block"


def rms_norm(x, g):
    xf = x.astype(jnp.float32)
    y = xf * lax.rsqrt(jnp.mean(xf * xf, axis=-1, keepdims=True) + EPS)
    return (y * g.astype(jnp.float32)).astype(x.dtype)


def neighbourhood_attention(q, k, v, rpb):
    B, S, H, dh = q.shape
    rows = S // GRID_W
    kr = min(NA_WIN_ROWS_MAX, rows)
    kc = NA_WIN_COLS
    qg = q.reshape(B, rows, GRID_W, H, dh)
    kg = k.reshape(B, rows, GRID_W, H, dh)
    vg = v.reshape(B, rows, GRID_W, H, dh)
    r = jnp.arange(rows)
    row_start = jnp.clip(r - kr // 2, 0, rows - kr)
    key_rows = row_start[:, None] + jnp.arange(kr)[None, :]
    k_band = kg[:, key_rows]
    v_band = vg[:, key_rows]
    cidx = jnp.arange(GRID_W)
    col_start = jnp.clip(cidx - kc // 2, 0, GRID_W - kc)
    in_win = (cidx[None, :] >= col_start[:, None]) & (cidx[None, :] < col_start[:, None] + kc)
    rel_r = key_rows - r[:, None] + NA_WIN_ROWS_MAX - 1
    rel_c = jnp.clip(cidx[None, :] - cidx[:, None], -(kc - 1), kc - 1) + NA_WIN_COLS - 1
    bias = rpb.astype(jnp.float32)[:, rel_r[:, None, :, None], rel_c[None, :, None, :]]
    s = jnp.einsum('brqhd,brjkhd->bhrqjk', qg, k_band).astype(jnp.float32) * (dh ** -0.5)
    s = s + bias[None]
    s = jnp.where(in_win[:, None, :], s, -jnp.inf)
    p = jax.nn.softmax(s.reshape(B, H, rows, GRID_W, kr * GRID_W), axis=-1)
    p = p.reshape(B, H, rows, GRID_W, kr, GRID_W).astype(v.dtype)
    o = jnp.einsum('bhrqjk,brjkhd->brqhd', p, v_band)
    return o.reshape(B, S, H * dh)


def t5_bucket(rel):
    nb = T5_BUCKETS // 2
    ret = jnp.where(rel > 0, nb, 0)
    n = jnp.abs(rel)
    max_exact = nb // 2
    nf = jnp.maximum(n, 1).astype(jnp.float32)
    large = max_exact + (jnp.log(nf / max_exact) / math.log(T5_MAX_DIST / max_exact)
                         * (nb - max_exact)).astype(jnp.int32)
    large = jnp.minimum(large, nb - 1)
    return ret + jnp.where(n < max_exact, n, large)


def differential_attention(q, k, v, t5_table, lam):
    B, S, H, _, dq = q.shape
    nblk = S // Q_BLOCK
    kpos = jnp.arange(S)
    q_blocks = jnp.moveaxis(q.reshape(B, nblk, Q_BLOCK, H, 2, dq), 1, 0)
    starts = jnp.arange(nblk) * Q_BLOCK
    table = t5_table.astype(jnp.float32)
    scale = dq ** -0.5

    def block_fn(args):
        qb, start = args
        qpos = start + jnp.arange(Q_BLOCK)
        bias = jnp.transpose(table[t5_bucket(kpos[None, :] - qpos[:, None])], (2, 0, 1))
        s = jnp.einsum('bqhmd,bkhmd->bhmqk', qb, k).astype(jnp.float32) * scale
        s = s + bias[None, :, None]
        p = jax.nn.softmax(s, axis=-1)
        a = (p[:, :, 0] - lam * p[:, :, 1]).astype(v.dtype)
        return jnp.einsum('bhqk,bkhd->bqhd', a, v)

    o = lax.map(block_fn, (q_blocks, starts))
    return jnp.moveaxis(o, 0, 1).reshape(B, S, H, v.shape[-1])


def setup_inputs(seed: int = 0) -> dict:
    key = jax.random.key(seed)
    ks = jax.random.split(key, 20)
    f32 = jnp.float32
    D = D_MODEL
    nrm = lambda k, shape, s: jax.random.normal(k, shape, f32) * s
    return {
        "x": nrm(ks[0], (BATCH, SEQ, D), 1.0),
        "c": nrm(ks[1], (BATCH, D), 1.0),
        "w_ada": nrm(ks[2], (DEPTH, D, 6 * D), 0.5 * D ** -0.5),
        "b_ada": nrm(ks[3], (DEPTH, 6 * D), 0.01),
        "norm1_g": 1.0 + nrm(ks[4], (DEPTH, D), 0.02),
        "w_in": nrm(ks[5], (DEPTH, D, PROJ_WIDTH), D ** -0.5),
        "na_rpb": nrm(ks[6], (DEPTH, NA_HEADS, 2 * NA_WIN_ROWS_MAX - 1, 2 * NA_WIN_COLS - 1), 0.5),
        "na_out_g": 1.0 + nrm(ks[7], (DEPTH, NA_WIDTH), 0.02),
        "da_lambda": nrm(ks[8], (DEPTH, 4, DA_QK_DIM), 0.1),
        "da_subln_g": 1.0 + nrm(ks[9], (DEPTH, HEAD_DIM), 0.02),
        "t5_table": nrm(ks[10], (T5_BUCKETS, DA_HEADS), 0.5),
        "w_out": nrm(ks[11], (DEPTH, MIX_WIDTH, D), MIX_WIDTH ** -0.5),
        "norm2_g": 1.0 + nrm(ks[12], (DEPTH, D), 0.02),
        "w_gate": nrm(ks[13], (DEPTH, D, D_FF), D ** -0.5),
        "w_up": nrm(ks[14], (DEPTH, D, D_FF), D ** -0.5),
        "w_down": nrm(ks[15], (DEPTH, D_FF, D), D_FF ** -0.5),
        "final_g": 1.0 + nrm(ks[16], (D,), 0.02),
    }


def reference(x, c, w_ada, b_ada, norm1_g, w_in, na_rpb, na_out_g, da_lambda, da_subln_g,
              t5_table, w_out, norm2_g, w_gate, w_up, w_down, final_g):
    B, S, D = x.shape
    cs = jax.nn.silu(c)
    o1 = NA_WIDTH
    o2 = o1 + NA_WIDTH
    o3 = o2 + NA_WIDTH
    o4 = o3 + DA_HEADS * 2 * DA_QK_DIM
    o5 = o4 + DA_HEADS * 2 * DA_QK_DIM
    for layer in range(DEPTH):
        mod = cs @ w_ada[layer] + b_ada[layer]
        sh1, sc1, g1, sh2, sc2, g2 = jnp.split(mod, 6, axis=-1)

        h = rms_norm(x, norm1_g[layer]) * (1 + sc1[:, None]) + sh1[:, None]
        proj = h @ w_in[layer]
        na_q = proj[..., :o1].reshape(B, S, NA_HEADS, HEAD_DIM)
        na_k = proj[..., o1:o2].reshape(B, S, NA_HEADS, HEAD_DIM)
        na_v = proj[..., o2:o3].reshape(B, S, NA_HEADS, HEAD_DIM)
        da_q = proj[..., o3:o4].reshape(B, S, DA_HEADS, 2, DA_QK_DIM)
        da_k = proj[..., o4:o5].reshape(B, S, DA_HEADS, 2, DA_QK_DIM)
        da_v = proj[..., o5:].reshape(B, S, DA_HEADS, HEAD_DIM)

        na_o = rms_norm(neighbourhood_attention(na_q, na_k, na_v, na_rpb[layer]), na_out_g[layer])

        lam_init = 0.8 - 0.6 * math.exp(-0.3 * layer)
        lp = da_lambda[layer].astype(jnp.float32)
        lam = jnp.exp(jnp.sum(lp[0] * lp[1])) - jnp.exp(jnp.sum(lp[2] * lp[3])) + lam_init
        da_o = differential_attention(da_q, da_k, da_v, t5_table, lam)
        da_o = (rms_norm(da_o, da_subln_g[layer]) * (1.0 - lam_init)).reshape(B, S, DA_WIDTH)

        mix = jnp.concatenate([na_o, da_o], axis=-1) @ w_out[layer]
        x = x + g1[:, None] * mix

        h2 = rms_norm(x, norm2_g[layer]) * (1 + sc2[:, None]) + sh2[:, None]
        ff = (jax.nn.silu(h2 @ w_gate[layer]) * (h2 @ w_up[layer])) @ w_down[layer]
        x = x + g2[:, None] * ff
    return rms_norm(x, final_g)
```

```cpp
#include <hip/hip_runtime.h>
#include <cstdio>
#include <cstdint>

typedef unsigned short bf16_t;
constexpr int BATCH = 4, SEQ = 2048, D = 2048, M = BATCH * SEQ;
constexpr int NH = 8, HD = 128, DQ = 64, PW = 6144, DFF = 5632;
constexpr int O_NAQ = 0, O_NAK = 1024, O_NAV = 2048, O_DAQ = 3072, O_DAK = 4096, O_DAV = 5120;
constexpr float EPS = 1e-6f;
constexpr float LOG2E = 1.4426950408889634f;
constexpr float C_NA = 0.08838834764831845f * LOG2E;
constexpr float C_DA = 0.125f * LOG2E;
constexpr float LAM_INIT = 0.2f;

constexpr size_t MiB = 1u << 20;
constexpr size_t WS_CTL = 0, CTL_BYTES = 1 * MiB;
constexpr size_t CTL_MOD = 64 * 1024;
constexpr size_t CTL_SSNA = 256 * 1024, CTL_SS1 = 288 * 1024, CTL_SS2 = 320 * 1024;
constexpr size_t WS_BGU = 1 * MiB;
constexpr size_t WS_WIN = 2 * MiB, WS_WOUT = 26 * MiB, WS_WGU = 34 * MiB, WS_WD = 78 * MiB;
constexpr size_t WS_H = 100 * MiB;
constexpr size_t WS_PROJ = 132 * MiB;
constexpr size_t WS_X1 = 228 * MiB;
constexpr size_t WS_A2 = 292 * MiB;
constexpr size_t WS_END = 324 * MiB;

__device__ __forceinline__ float bf2f(bf16_t v) { return __uint_as_float(((unsigned)v) << 16); }
__device__ __forceinline__ bf16_t f2bf(float f) { unsigned u = __float_as_uint(f); return (bf16_t)((u + 0x7fffu + ((u >> 16) & 1u)) >> 16); }
__device__ __forceinline__ float silu_f(float v) { return v / (1.f + __expf(-v)); }
__device__ __forceinline__ int t5_bucket(int rel) {
    const int n = rel < 0 ? -rel : rel; int b;
    if (n < 8) b = n; else if (n < 12) b = 8; else if (n < 16) b = 9; else if (n < 23) b = 10; else if (n < 32) b = 11;
    else if (n < 46) b = 12; else if (n < 64) b = 13; else if (n < 91) b = 14; else b = 15;
    return b + (rel > 0 ? 16 : 0);
}
__device__ __forceinline__ float block_sum(float v, float* red) {
    for (int o = 32; o > 0; o >>= 1) v += __shfl_xor(v, o);
    __syncthreads();
    if ((threadIdx.x & 63) == 0) red[threadIdx.x >> 6] = v;
    __syncthreads();
    float s = 0.f; for (int i = 0; i < (int)(blockDim.x >> 6); ++i) s += red[i];
    return s;
}
__device__ __forceinline__ float block_max(float v, float* red) {
    for (int o = 32; o > 0; o >>= 1) v = fmaxf(v, __shfl_xor(v, o));
    __syncthreads();
    if ((threadIdx.x & 63) == 0) red[threadIdx.x >> 6] = v;
    __syncthreads();
    float s = -INFINITY; for (int i = 0; i < (int)(blockDim.x >> 6); ++i) s = fmaxf(s, red[i]);
    return s;
}

__global__ __launch_bounds__(256) void n_mod(const float* c, const float* w_ada, const float* b_ada, float* mod) {
    __shared__ float cs[4][64];
    const int n = blockIdx.x * 256 + threadIdx.x, kc = blockIdx.y;
    { const int b = threadIdx.x >> 6, k = threadIdx.x & 63; cs[b][k] = silu_f(c[b * D + kc * 64 + k]); }
    __syncthreads();
    float a0 = 0, a1 = 0, a2 = 0, a3 = 0;
    for (int k = 0; k < 64; ++k) { const float w = w_ada[(size_t)(kc * 64 + k) * (6 * D) + n]; a0 += cs[0][k] * w; a1 += cs[1][k] * w; a2 += cs[2][k] * w; a3 += cs[3][k] * w; }
    if (kc == 0) { const float bb = b_ada[n]; a0 += bb; a1 += bb; a2 += bb; a3 += bb; }
    atomicAdd(&mod[0 * 6 * D + n], a0); atomicAdd(&mod[1 * 6 * D + n], a1); atomicAdd(&mod[2 * 6 * D + n], a2); atomicAdd(&mod[3 * 6 * D + n], a3);
}
__global__ __launch_bounds__(256) void n_h(const float* x, const float* mod, const float* g, bf16_t* H) {
    __shared__ float red[64];
    const int m = blockIdx.x, b = m / SEQ; const float* xr = x + (size_t)m * D;
    float v[8]; float ss = 0.f;
    for (int j = 0; j < 8; ++j) { v[j] = xr[threadIdx.x + 256 * j]; ss += v[j] * v[j]; }
    ss = block_sum(ss, red);
    const float rstd = rsqrtf(ss / D + EPS);
    for (int j = 0; j < 8; ++j) { const int col = threadIdx.x + 256 * j; const float sh = mod[b * 6 * D + col], sc = mod[b * 6 * D + D + col];
        H[(size_t)m * D + col] = f2bf(v[j] * rstd * g[col] * (1.f + sc) + sh); }
}
template <class Epi, bool DUAL>
__global__ __launch_bounds__(256) void gemm_naive(const bf16_t* A, int lda, const float* B0, const float* B1, int ldb, int K, const float* rowss, int kscale, Epi epi) {
    __shared__ float As[16][65]; __shared__ float Bs[16][64]; __shared__ float Bs1[16][64];
    const int t = threadIdx.x, tx = t & 15, ty = t >> 4, m0 = blockIdx.y * 64, n0 = blockIdx.x * 64;
    float acc[4][4] = {}, acc1[4][4] = {};
    const int ar = t >> 2, ak = (t & 3) * 4, bk = t >> 4, bn = (t & 15) * 4;
    float rsc = 1.f; if (rowss) rsc = rsqrtf(rowss[m0 + ar] / 1024.f + EPS);
    for (int k0 = 0; k0 < K; k0 += 16) {
        const float sc = (k0 < kscale) ? rsc : 1.f;
        for (int i = 0; i < 4; ++i) As[ak + i][ar] = bf2f(A[(size_t)(m0 + ar) * lda + k0 + ak + i]) * sc;
        { const float4 w = *(const float4*)(B0 + (size_t)(k0 + bk) * ldb + n0 + bn); Bs[bk][bn] = w.x; Bs[bk][bn + 1] = w.y; Bs[bk][bn + 2] = w.z; Bs[bk][bn + 3] = w.w; }
        if (DUAL) { const float4 w = *(const float4*)(B1 + (size_t)(k0 + bk) * ldb + n0 + bn); Bs1[bk][bn] = w.x; Bs1[bk][bn + 1] = w.y; Bs1[bk][bn + 2] = w.z; Bs1[bk][bn + 3] = w.w; }
        __syncthreads();
#pragma unroll
        for (int kk = 0; kk < 16; ++kk) {
            float a[4], b[4], b1[4];
            for (int i = 0; i < 4; ++i) a[i] = As[kk][ty * 4 + i];
            for (int j = 0; j < 4; ++j) { b[j] = Bs[kk][tx * 4 + j]; if (DUAL) b1[j] = Bs1[kk][tx * 4 + j]; }
            for (int i = 0; i < 4; ++i) for (int j = 0; j < 4; ++j) { acc[i][j] += a[i] * b[j]; if (DUAL) acc1[i][j] += a[i] * b1[j]; }
        }
        __syncthreads();
    }
    for (int i = 0; i < 4; ++i) for (int j = 0; j < 4; ++j) epi(m0 + ty * 4 + i, n0 + tx * 4 + j, acc[i][j], acc1[i][j]);
}
struct EpiProj { bf16_t* P; __device__ void operator()(int r, int c, float v, float) const {
    const float s = (c < 1024) ? C_NA : ((c >= O_DAQ && c < O_DAK) ? C_DA : 1.f); P[(size_t)r * PW + c] = f2bf(v * s); } };
struct EpiMix { const float* x; const float* mod; const float* g2n; float* X1; bf16_t* A2; float* ss1;
    __device__ void operator()(int r, int c, float v, float) const { const int b = r / SEQ;
        const float x1 = x[(size_t)r * D + c] + mod[b * 6 * D + 2 * D + c] * v; X1[(size_t)r * D + c] = x1;
        A2[(size_t)r * D + c] = f2bf(x1 * g2n[c] * (1.f + mod[b * 6 * D + 4 * D + c])); atomicAdd(&ss1[r], x1 * x1); } };
struct EpiGU { const float* ss1; const float* bgu; bf16_t* ACT;
    __device__ void operator()(int r, int c, float g, float u) const { const int b = r / SEQ; const float rstd = rsqrtf(ss1[r] / D + EPS);
        const float gv = g * rstd + bgu[b * 2 * DFF + c], uv = u * rstd + bgu[b * 2 * DFF + DFF + c]; ACT[(size_t)r * DFF + c] = f2bf(silu_f(gv) * uv); } };
struct EpiDown { const float* X1; const float* mod; float* X2; float* ss2;
    __device__ void operator()(int r, int c, float v, float) const { const int b = r / SEQ;
        const float x2 = X1[(size_t)r * D + c] + mod[b * 6 * D + 5 * D + c] * v; X2[(size_t)r * D + c] = x2; atomicAdd(&ss2[r], x2 * x2); } };
__global__ __launch_bounds__(256) void n_bgu(const float* mod, const float* wg, const float* wu, float* bgu) {
    const int n = blockIdx.x * 256 + threadIdx.x; if (n >= 2 * DFF) return;
    const float* W = n < DFF ? wg : wu; const int c = n < DFF ? n : n - DFF;
    float a[4] = {0, 0, 0, 0};
    for (int k = 0; k < D; ++k) { const float w = W[(size_t)k * DFF + c]; for (int b = 0; b < 4; ++b) a[b] += mod[b * 6 * D + 3 * D + k] * w; }
    for (int b = 0; b < 4; ++b) bgu[b * 2 * DFF + n] = a[b];
}
__global__ __launch_bounds__(128) void n_na(const bf16_t* P, const float* rpb, const float* gout, bf16_t* AO, float* ssna) {
    __shared__ float q[128], p[128], red[64];
    const int m = blockIdx.x, h = blockIdx.y, t = threadIdx.x, b = m / SEQ, s = m % SEQ, r = s / 64, qc = s % 64;
    const int rs = min(max(r - 4, 0), 24), cs = min(max(qc - 8, 0), 48);
    q[t] = bf2f(P[(size_t)m * PW + O_NAQ + h * HD + t]);
    __syncthreads();
    const int jr = t >> 4, jc = t & 15, kr = rs + jr, kc = cs + jc; const size_t kt = (size_t)b * SEQ + kr * 64 + kc;
    const bf16_t* kp = P + kt * PW + O_NAK + h * HD;
    float sc = 0.f; for (int d = 0; d < HD; ++d) sc += q[d] * bf2f(kp[d]);
    sc += rpb[(h * 15 + (kr - r + 7)) * 31 + (kc - qc + 15)] * LOG2E;
    const float mx = block_max(sc, red); const float e = exp2f(sc - mx); const float l = block_sum(e, red);
    p[t] = e / l; __syncthreads();
    float o = 0.f;
    for (int j = 0; j < 128; ++j) { const size_t vt = (size_t)b * SEQ + (rs + (j >> 4)) * 64 + cs + (j & 15); o += p[j] * bf2f(P[vt * PW + O_NAV + h * HD + t]); }
    AO[(size_t)m * D + h * HD + t] = f2bf(o * gout[h * HD + t]);
    const float ss = block_sum(o * o, red); if (t == 0) atomicAdd(&ssna[m], ss);
}
__global__ __launch_bounds__(256) void n_da(const bf16_t* P, const float* t5, const float* lamp, const float* subg, bf16_t* AO) {
    __shared__ float q[128], s1[SEQ], s2[SEQ], red[64], oh[128];
    const int m = blockIdx.x, h = blockIdx.y, t = threadIdx.x, b = m / SEQ, s = m % SEQ;
    if (t < 128) q[t] = bf2f(P[(size_t)m * PW + O_DAQ + h * HD + t]);
    float lp = 0.f; if (t < 64) lp = lamp[t] * lamp[64 + t]; else if (t < 128) lp = -0.f + lamp[128 + (t - 64)] * lamp[192 + (t - 64)];
    __syncthreads();
    const float sA = block_sum(t < 64 ? lp : 0.f, red), sB = block_sum((t >= 64 && t < 128) ? lp : 0.f, red);
    const float lam = __expf(sA) - __expf(sB) + LAM_INIT;
    float m1 = -INFINITY, m2 = -INFINITY;
    for (int kk = t; kk < SEQ; kk += 256) { const bf16_t* kp = P + ((size_t)b * SEQ + kk) * PW + O_DAK + h * HD;
        float a = 0.f, c2 = 0.f;
        for (int d8 = 0; d8 < 8; ++d8) { const uint4 u = *(const uint4*)(kp + d8 * 8), w = *(const uint4*)(kp + 64 + d8 * 8);
            const unsigned uu[4] = {u.x, u.y, u.z, u.w}, ww[4] = {w.x, w.y, w.z, w.w};
            for (int e = 0; e < 4; ++e) { a += q[d8 * 8 + 2 * e] * __uint_as_float(uu[e] << 16) + q[d8 * 8 + 2 * e + 1] * __uint_as_float(uu[e] & 0xffff0000u);
                c2 += q[64 + d8 * 8 + 2 * e] * __uint_as_float(ww[e] << 16) + q[64 + d8 * 8 + 2 * e + 1] * __uint_as_float(ww[e] & 0xffff0000u); } }
        const float bias = t5[t5_bucket(kk - s) * NH + h] * LOG2E; a += bias; c2 += bias; s1[kk] = a; s2[kk] = c2; m1 = fmaxf(m1, a); m2 = fmaxf(m2, c2); }
    m1 = block_max(m1, red); m2 = block_max(m2, red);
    float l1 = 0.f, l2 = 0.f;
    for (int kk = t; kk < SEQ; kk += 256) { const float e1 = exp2f(s1[kk] - m1), e2 = exp2f(s2[kk] - m2); s1[kk] = e1; s2[kk] = e2; l1 += e1; l2 += e2; }
    l1 = block_sum(l1, red); l2 = block_sum(l2, red);
    __syncthreads();
    const int d = t & 127, part = t >> 7; float o = 0.f;
    for (int kk = part * 1024; kk < part * 1024 + 1024; ++kk) { const float a = s1[kk] / l1 - lam * (s2[kk] / l2); o += a * bf2f(P[((size_t)b * SEQ + kk) * PW + O_DAV + h * HD + d]); }
    if (part == 1) oh[d] = o; __syncthreads(); if (part == 0) o += oh[d];
    const float ss = block_sum(part == 0 ? o * o : 0.f, red);
    if (part == 0) AO[(size_t)m * D + 1024 + h * HD + d] = f2bf(o * rsqrtf(ss / HD + EPS) * subg[d] * (1.f - LAM_INIT));
}
__global__ __launch_bounds__(256) void n_final(float* out, const float* ss2, const float* fg) {
    const int m = blockIdx.x; const float rstd = rsqrtf(ss2[m] / D + EPS);
    for (int j = 0; j < 8; ++j) { const int col = threadIdx.x + 256 * j; out[(size_t)m * D + col] = out[(size_t)m * D + col] * rstd * fg[col]; }
}

extern "C" void kernel_launch(void* const* d_in, const int* in_sizes, int n_in, void* d_out, int out_size, void* d_ws, size_t ws_size, hipStream_t stream) {
    if (n_in != 17 || out_size != M * D || ws_size < WS_END) { fprintf(stderr, "kernel_launch: unexpected shapes n_in %d out %d ws %zu\n", n_in, out_size, ws_size); return; }
    const float* x = (const float*)d_in[0]; const float* c = (const float*)d_in[1]; const float* w_ada = (const float*)d_in[2]; const float* b_ada = (const float*)d_in[3];
    const float* norm1_g = (const float*)d_in[4]; const float* w_in = (const float*)d_in[5]; const float* na_rpb = (const float*)d_in[6]; const float* na_out_g = (const float*)d_in[7];
    const float* da_lambda = (const float*)d_in[8]; const float* da_subln_g = (const float*)d_in[9]; const float* t5_table = (const float*)d_in[10]; const float* w_out = (const float*)d_in[11];
    const float* norm2_g = (const float*)d_in[12]; const float* w_gate = (const float*)d_in[13]; const float* w_up = (const float*)d_in[14]; const float* w_down = (const float*)d_in[15];
    const float* final_g = (const float*)d_in[16];
    char* ws = (char*)d_ws; float* out = (float*)d_out;
    float* mod = (float*)(ws + CTL_MOD); float* ssna = (float*)(ws + CTL_SSNA); float* ss1 = (float*)(ws + CTL_SS1); float* ss2 = (float*)(ws + CTL_SS2);
    float* bgu = (float*)(ws + WS_BGU); bf16_t* H = (bf16_t*)(ws + WS_H); bf16_t* AO = H; bf16_t* PROJ = (bf16_t*)(ws + WS_PROJ); bf16_t* ACT = PROJ;
    float* X1 = (float*)(ws + WS_X1); bf16_t* A2 = (bf16_t*)(ws + WS_A2);
    hipMemsetAsync(ws + WS_CTL, 0, CTL_BYTES, stream);
    n_mod<<<dim3(48, 32), 256, 0, stream>>>(c, w_ada, b_ada, mod);
    n_h<<<M, 256, 0, stream>>>(x, mod, norm1_g, H);
    gemm_naive<EpiProj, false><<<dim3(PW / 64, M / 64), 256, 0, stream>>>(H, D, w_in, nullptr, PW, D, nullptr, 0, EpiProj{PROJ});
    n_na<<<dim3(M, NH), 128, 0, stream>>>(PROJ, na_rpb, na_out_g, AO, ssna);
    n_da<<<dim3(M, NH), 256, 0, stream>>>(PROJ, t5_table, da_lambda, da_subln_g, AO);
    n_bgu<<<(2 * DFF + 255) / 256, 256, 0, stream>>>(mod, w_gate, w_up, bgu);
    gemm_naive<EpiMix, false><<<dim3(D / 64, M / 64), 256, 0, stream>>>(AO, D, w_out, nullptr, D, D, ssna, 1024, EpiMix{x, mod, norm2_g, X1, A2, ss1});
    gemm_naive<EpiGU, true><<<dim3(DFF / 64, M / 64), 256, 0, stream>>>(A2, D, w_gate, w_up, DFF, D, nullptr, 0, EpiGU{ss1, bgu, ACT});
    gemm_naive<EpiDown, false><<<dim3(D / 64, M / 64), 256, 0, stream>>>(ACT, DFF, w_down, nullptr, D, DFF, nullptr, 0, EpiDown{X1, mod, out, ss2});
    n_final<<<M, 256, 0, stream>>>(out, ss2, final_g);
}
```

```cpp
#include <hip/hip_runtime.h>
#include <cstdio>
#include <cstdint>

typedef unsigned short bf16_t;
constexpr int BATCH = 4, SEQ = 2048, D = 2048, M = BATCH * SEQ;
constexpr int NH = 8, HD = 128, DQ = 64, PW = 6144, DFF = 5632;
constexpr int O_NAQ = 0, O_NAK = 1024, O_NAV = 2048, O_DAQ = 3072, O_DAK = 4096, O_DAV = 5120;
constexpr float EPS = 1e-6f;
constexpr float LOG2E = 1.4426950408889634f;
constexpr float C_NA = 0.08838834764831845f * LOG2E;
constexpr float C_DA = 0.125f * LOG2E;
constexpr float LAM_INIT = 0.2f;

constexpr size_t MiB = 1u << 20;
constexpr size_t WS_CTL = 0, CTL_BYTES = 1 * MiB;
constexpr int    CW_BAR = 4096;
constexpr size_t CTL_MOD = 128 * 1024;
constexpr size_t CTL_SSNA = 320 * 1024, CTL_SS1 = 352 * 1024, CTL_SS2 = 384 * 1024;
constexpr size_t WS_BGU = 1 * MiB;
constexpr size_t WS_WIN = 2 * MiB, WS_WOUT = 26 * MiB, WS_WGU = 34 * MiB, WS_WD = 78 * MiB;
constexpr size_t WS_H = 100 * MiB;
constexpr size_t WS_PROJ = 132 * MiB;
constexpr size_t WS_X1 = 228 * MiB;
constexpr size_t WS_A2 = 292 * MiB;
constexpr size_t WS_END = 324 * MiB;

__device__ __forceinline__ float bf2f(bf16_t v) { return __uint_as_float(((unsigned)v) << 16); }
__device__ __forceinline__ bf16_t f2bf(float f) { unsigned u = __float_as_uint(f); return (bf16_t)((u + 0x7fffu + ((u >> 16) & 1u)) >> 16); }
__device__ __forceinline__ unsigned pk2(float lo, float hi) { return (unsigned)f2bf(lo) | ((unsigned)f2bf(hi) << 16); }
__device__ __forceinline__ float silu_f(float v) { return v / (1.f + __expf(-v)); }
__device__ __forceinline__ float silu_fast(float v) { return v * __builtin_amdgcn_rcpf(1.f + __builtin_amdgcn_exp2f(-v * LOG2E)); }
__device__ __forceinline__ int t5_bucket(int rel) {
    const int n = rel < 0 ? -rel : rel; int b;
    if (n < 8) b = n; else if (n < 12) b = 8; else if (n < 16) b = 9; else if (n < 23) b = 10; else if (n < 32) b = 11;
    else if (n < 46) b = 12; else if (n < 64) b = 13; else if (n < 91) b = 14; else b = 15;
    return b + (rel > 0 ? 16 : 0);
}

namespace pg8 {
#define PG8_LAS __attribute__((address_space(3)))
typedef short bf16x8 __attribute__((ext_vector_type(8)));
typedef float f32x4 __attribute__((ext_vector_type(4)));
typedef unsigned u32x4 __attribute__((ext_vector_type(4)));
constexpr int BM = 256, BK = 64, HALF = 128, HTB = HALF * BK * 2  , STAGE_BYTES = 8 * HTB, NXCD = 8, WGM = 8;

__host__ __device__ __forceinline__ int lds_byte(int r, int c) { const int st = (r >> 4) * 2 + (c >> 5), rr = r & 15, cc = c & 31, ob = rr * 64 + cc * 2; return st * 1024 + (ob ^ (((ob >> 9) & 1) << 5)); }
__host__ __device__ __forceinline__ void stage_rc(int b, int& R, int& C) { const int st = b / 1024, sb = b % 1024, swz = sb ^ (((sb >> 9) & 1) << 5); R = (st >> 1) * 16 + swz / 64; C = (st & 1) * 32 + (swz % 64) / 2; }
__host__ __device__ __forceinline__ int perm32(int rho) { const int n = rho >> 4, i = rho & 15; return 8 * (i >> 2) + 4 * n + (i & 3); }

struct Unit { int pm, pn; };
struct Gemm { const bf16_t* A; const bf16_t* Bt; int M, N, K; };

struct StaticOrder {
    int nM, nN, nwg, G, c;
    __host__ __device__ void init(int M, int N, int G_, int c_) { nM = M / BM; nN = N / BM; nwg = nM * nN; G = G_; c = c_; }
    __host__ __device__ bool next(int i, Unit& u) const {
        const long L = (long)i * G + c; if (L >= nwg) return false;
        int wgid = (int)L; { const int q = nwg / NXCD, r = nwg % NXCD, xcd = wgid % NXCD, off = wgid / NXCD; wgid = (xcd < r ? xcd * (q + 1) : r * (q + 1) + (xcd - r) * q) + off; }
        const int nig = WGM * nN, gid = wgid / nig, fm = gid * WGM, gsz = (nM - fm) < WGM ? (nM - fm) : WGM;
        u.pm = fm + ((wgid % nig) % gsz); u.pn = (wgid % nig) / gsz; return true;
    }
    __device__ __forceinline__ void a_ready(const Unit&) const {}
    __device__ __forceinline__ void done(const Unit&) const {}
};
__device__ __forceinline__ unsigned cvt_pk_bf16(float lo, float hi) { unsigned r; asm volatile("v_cvt_pk_bf16_f32 %0, %1, %2" : "=v"(r) : "v"(lo), "v"(hi)); return r; }

struct EpiProj {
    static constexpr bool PERM = true, AFTER_DRAIN = false; static constexpr int MIDK_T = -1;
    bf16_t* O;
    __device__ __forceinline__ void midk(f32x4 (&)[2][2][4][2], const Unit&, int, int, int, int) const {}
    __device__ __forceinline__ void operator()(const f32x4 (&acc)[2][2][4][2], const Unit& u, int wr, int wc, int fr, int fq) const {
        const int row0 = u.pm * BM + wr * 64 + fr, col0 = u.pn * BM + wc * 32 + 8 * fq;
#pragma unroll
        for (int ai = 0; ai < 2; ++ai)
#pragma unroll
            for (int m = 0; m < 4; ++m) { bf16_t* rowp = O + (size_t)(row0 + ai * HALF + m * 16) * PW + col0;
#pragma unroll
                for (int bj = 0; bj < 2; ++bj) { const f32x4 v0 = acc[ai][bj][m][0], v1 = acc[ai][bj][m][1];
                    u32x4 w; w.x = cvt_pk_bf16(v0[0], v0[1]); w.y = cvt_pk_bf16(v0[2], v0[3]); w.z = cvt_pk_bf16(v1[0], v1[1]); w.w = cvt_pk_bf16(v1[2], v1[3]);
                    *(u32x4*)(rowp + bj * HALF) = w; } }
    }
};
struct EpiMix {
    static constexpr bool PERM = true, AFTER_DRAIN = false; static constexpr int MIDK_T = 16;
    const float* x; const float* mod; const float* g2n; const float* ssna; float* X1; bf16_t* A2; float* ss1;
    __device__ __forceinline__ void midk(f32x4 (&acc)[2][2][4][2], const Unit& u, int wr, int wc, int fr, int fq) const {
        const int row0 = u.pm * BM + wr * 64 + fr;
#pragma unroll
        for (int ai = 0; ai < 2; ++ai)
#pragma unroll
            for (int m = 0; m < 4; ++m) { const float r = rsqrtf(ssna[row0 + ai * HALF + m * 16] * (1.f / 1024.f) + EPS);
#pragma unroll
                for (int bj = 0; bj < 2; ++bj)
#pragma unroll
                    for (int n = 0; n < 2; ++n) acc[ai][bj][m][n] *= r; }
    }
    __device__ __forceinline__ void operator()(const f32x4 (&acc)[2][2][4][2], const Unit& u, int wr, int wc, int fr, int fq) const {
        const int row0 = u.pm * BM + wr * 64 + fr, col0 = u.pn * BM + wc * 32 + 8 * fq, b = u.pm >> 3;
        const float* mb = mod + (size_t)b * 6 * D;
        f32x4 g1v[2][2], gmv[2][2];
#pragma unroll
        for (int bj = 0; bj < 2; ++bj)
#pragma unroll
            for (int n = 0; n < 2; ++n) { const int c = col0 + bj * HALF + 4 * n; g1v[bj][n] = *(const f32x4*)(mb + 2 * D + c);
                const f32x4 sc = *(const f32x4*)(mb + 4 * D + c), gn = *(const f32x4*)(g2n + c); gmv[bj][n] = gn * (sc + 1.0f); }
#pragma unroll
        for (int ai = 0; ai < 2; ++ai)
#pragma unroll
            for (int m = 0; m < 4; ++m) { const int row = row0 + ai * HALF + m * 16; const size_t off = (size_t)row * D + col0; float ss = 0.f;
#pragma unroll
                for (int bj = 0; bj < 2; ++bj) { f32x4 x1[2];
#pragma unroll
                    for (int n = 0; n < 2; ++n) { const f32x4 xv = *(const f32x4*)(x + off + bj * HALF + 4 * n); x1[n] = xv + g1v[bj][n] * acc[ai][bj][m][n];
                        *(f32x4*)(X1 + off + bj * HALF + 4 * n) = x1[n]; ss += (x1[n][0] * x1[n][0] + x1[n][1] * x1[n][1]) + (x1[n][2] * x1[n][2] + x1[n][3] * x1[n][3]); }
                    const f32x4 a0 = x1[0] * gmv[bj][0], a1 = x1[1] * gmv[bj][1];
                    u32x4 w; w.x = cvt_pk_bf16(a0[0], a0[1]); w.y = cvt_pk_bf16(a0[2], a0[3]); w.z = cvt_pk_bf16(a1[0], a1[1]); w.w = cvt_pk_bf16(a1[2], a1[3]);
                    *(u32x4*)(A2 + off + bj * HALF) = w; }
                ss += __shfl_xor(ss, 16); ss += __shfl_xor(ss, 32);
                if (fq == 0) atomicAdd(ss1 + row, ss); }
    }
};
struct EpiGU {
    static constexpr bool PERM = true, AFTER_DRAIN = false; static constexpr int MIDK_T = -1;
    const float* ss1; const float* bgu; bf16_t* ACT;
    __device__ __forceinline__ void midk(f32x4 (&)[2][2][4][2], const Unit&, int, int, int, int) const {}
    __device__ __forceinline__ void operator()(const f32x4 (&acc)[2][2][4][2], const Unit& u, int wr, int wc, int fr, int fq) const {
        const int row0 = u.pm * BM + wr * 64 + fr, colo = u.pn * HALF + wc * 32 + 8 * fq, b = u.pm >> 3;
        const float* bb = bgu + (size_t)b * 2 * DFF;
        f32x4 bg[2], bu[2];
#pragma unroll
        for (int n = 0; n < 2; ++n) { bg[n] = *(const f32x4*)(bb + colo + 4 * n); bu[n] = *(const f32x4*)(bb + DFF + colo + 4 * n); }
#pragma unroll
        for (int ai = 0; ai < 2; ++ai)
#pragma unroll
            for (int m = 0; m < 4; ++m) { const int row = row0 + ai * HALF + m * 16; const float rstd = rsqrtf(ss1[row] * (1.f / D) + EPS);
                float o[8];
#pragma unroll
                for (int n = 0; n < 2; ++n) { const f32x4 g = acc[ai][0][m][n] * rstd + bg[n], uu = acc[ai][1][m][n] * rstd + bu[n];
#pragma unroll
                    for (int j = 0; j < 4; ++j) o[4 * n + j] = silu_fast(g[j]) * uu[j]; }
                u32x4 w; w.x = cvt_pk_bf16(o[0], o[1]); w.y = cvt_pk_bf16(o[2], o[3]); w.z = cvt_pk_bf16(o[4], o[5]); w.w = cvt_pk_bf16(o[6], o[7]);
                *(u32x4*)(ACT + (size_t)row * DFF + colo) = w; }
    }
};
struct EpiDown {
    static constexpr bool PERM = true, AFTER_DRAIN = false; static constexpr int MIDK_T = -1;
    const float* X1; const float* mod; float* X2; float* ss2;
    __device__ __forceinline__ void midk(f32x4 (&)[2][2][4][2], const Unit&, int, int, int, int) const {}
    __device__ __forceinline__ void operator()(const f32x4 (&acc)[2][2][4][2], const Unit& u, int wr, int wc, int fr, int fq) const {
        const int row0 = u.pm * BM + wr * 64 + fr, col0 = u.pn * BM + wc * 32 + 8 * fq, b = u.pm >> 3;
        const float* mb = mod + (size_t)b * 6 * D + 5 * D;
        f32x4 g2v[2][2];
#pragma unroll
        for (int bj = 0; bj < 2; ++bj)
#pragma unroll
            for (int n = 0; n < 2; ++n) g2v[bj][n] = *(const f32x4*)(mb + col0 + bj * HALF + 4 * n);
#pragma unroll
        for (int ai = 0; ai < 2; ++ai)
#pragma unroll
            for (int m = 0; m < 4; ++m) { const int row = row0 + ai * HALF + m * 16; const size_t off = (size_t)row * D + col0; float ss = 0.f;
#pragma unroll
                for (int bj = 0; bj < 2; ++bj)
#pragma unroll
                    for (int n = 0; n < 2; ++n) { const f32x4 xv = *(const f32x4*)(X1 + off + bj * HALF + 4 * n); const f32x4 x2 = xv + g2v[bj][n] * acc[ai][bj][m][n];
                        *(f32x4*)(X2 + off + bj * HALF + 4 * n) = x2; ss += (x2[0] * x2[0] + x2[1] * x2[1]) + (x2[2] * x2[2] + x2[3] * x2[3]); }
                ss += __shfl_xor(ss, 16); ss += __shfl_xor(ss, 32);
                if (fq == 0) atomicAdd(ss2 + row, ss); }
    }
};

template <class Epi, class Sched, bool ALIGN_EPI = false, bool SP2 = false>
__device__ __forceinline__ void gemm_phase(PG8_LAS unsigned char* lds, const Gemm g, const Sched& S, const Epi& E) {
    const int tid = threadIdx.x, wid = __builtin_amdgcn_readfirstlane(tid >> 6), lane = tid & 63, wr = wid >> 2, wc = wid & 3, fr = lane & 15, fq = lane >> 4;
    const int K = g.K, nt = K / BK;
    unsigned voffA[2], voffB[2];
#pragma unroll
    for (int i = 0; i < 2; ++i) { int R, C; stage_rc(tid * 16 + i * 8192, R, C); const int Rb = Epi::PERM ? ((R & ~31) + perm32(R & 31)) : R;
        voffA[i] = (unsigned)(R * K + C) * 2u; voffB[i] = (unsigned)(Rb * K + C) * 2u; }
    const size_t kstep = (size_t)(BK * 2);
    const size_t hstep = (size_t)HALF * K * 2;
    const size_t tstep = 2 * hstep;
    const unsigned ldsw = (unsigned)wid * 1024u;
    const int aoff = lds_byte(wr * 64 + fr, fq * 8), boff = lds_byte(wc * 32 + fr, fq * 8);
#define PG8_SA(b, h) (((b) * 2 + (h)) * HTB)
#define PG8_SB(b, h) ((4 + (b) * 2 + (h)) * HTB)
#define PG8_STAGE(bufoff, gbase, voff) do { _Pragma("unroll") for (int _i = 0; _i < 2; ++_i) \
        __builtin_amdgcn_global_load_lds((const unsigned*)((const char*)(gbase) + (voff)[_i]), (PG8_LAS unsigned*)(lds + (bufoff) + ldsw + _i * 8192), 16, 0, 0); } while (0)
#define PG8_LDA(dst, b, h) do { _Pragma("unroll") for (int m = 0; m < 4; ++m) _Pragma("unroll") for (int k = 0; k < 2; ++k) dst[m][k] = *(const PG8_LAS bf16x8*)(lds + PG8_SA(b, h) + aoff + m * 2048 + k * 1024); } while (0)
#define PG8_LDB(dst, b, h) do { _Pragma("unroll") for (int n = 0; n < 2; ++n) _Pragma("unroll") for (int k = 0; k < 2; ++k) dst[n][k] = *(const PG8_LAS bf16x8*)(lds + PG8_SB(b, h) + boff + n * 2048 + k * 1024); } while (0)
#define PG8_MMA(ai, bj, At, Bt) do { __builtin_amdgcn_s_setprio(1); _Pragma("unroll") for (int m = 0; m < 4; ++m) _Pragma("unroll") for (int n = 0; n < 2; ++n) _Pragma("unroll") for (int k = 0; k < 2; ++k) \
        acc[ai][bj][m][n] = __builtin_amdgcn_mfma_f32_16x16x32_bf16(Bt[n][k], At[m][k], acc[ai][bj][m][n], 0, 0, 0); __builtin_amdgcn_s_setprio(0); } while (0)
#define PG8_WAIT_V(n) asm volatile("s_waitcnt vmcnt(" #n ")" ::: "memory")
#define PG8_WAIT_L(n) asm volatile("s_waitcnt lgkmcnt(" #n ")" ::: "memory")
#define PG8_BAR __builtin_amdgcn_s_barrier()
#define PG8_SCHED __builtin_amdgcn_sched_barrier(0)
    Unit cur, nxt; int ui = 0;
    if (!S.next(0, cur)) return;
    f32x4 acc[2][2][4][2];
#pragma unroll
    for (int a = 0; a < 2; ++a)
#pragma unroll
        for (int b = 0; b < 2; ++b)
#pragma unroll
            for (int m = 0; m < 4; ++m)
#pragma unroll
                for (int n = 0; n < 2; ++n) acc[a][b][m][n] = (f32x4){0.f, 0.f, 0.f, 0.f};
    bf16x8 At[4][2], B0[2][2], B1[2][2];
    const char* cA = (const char*)g.A + (size_t)cur.pm * tstep; const char* cB = (const char*)g.Bt + (size_t)cur.pn * tstep;
    S.a_ready(cur);
    if constexpr (SP2) {
        PG8_STAGE(PG8_SB(0, 0), cB, voffB); PG8_STAGE(PG8_SB(0, 1), cB + hstep, voffB); PG8_STAGE(PG8_SA(0, 0), cA, voffA); PG8_STAGE(PG8_SA(0, 1), cA + hstep, voffA);
        if (wr == 1) PG8_BAR;
        PG8_WAIT_V(2); PG8_BAR;
        PG8_STAGE(PG8_SB(1, 0), cB + kstep, voffB); PG8_STAGE(PG8_SA(1, 0), cA + kstep, voffA); PG8_STAGE(PG8_SB(1, 1), cB + hstep + kstep, voffB);
        PG8_WAIT_V(6); PG8_BAR;
    } else {
        PG8_STAGE(PG8_SB(0, 0), cB, voffB); PG8_STAGE(PG8_SA(0, 0), cA, voffA); PG8_STAGE(PG8_SB(0, 1), cB + hstep, voffB); PG8_STAGE(PG8_SA(0, 1), cA + hstep, voffA);
        if (wr == 1) PG8_BAR;
        PG8_WAIT_V(4); PG8_BAR;
        PG8_STAGE(PG8_SB(1, 0), cB + kstep, voffB); PG8_STAGE(PG8_SA(1, 0), cA + kstep, voffA); PG8_STAGE(PG8_SB(1, 1), cB + hstep + kstep, voffB);
        PG8_WAIT_V(6); PG8_BAR;
    }
    for (;;) {
        const bool has_next = S.next(ui + 1, nxt);
        const char* nA = has_next ? (const char*)g.A + (size_t)nxt.pm * tstep : cA; const char* nB = has_next ? (const char*)g.Bt + (size_t)nxt.pn * tstep : cB;
        for (int t = 0; t < nt; t += 2) {
            if constexpr (Epi::MIDK_T >= 0) { if (t == Epi::MIDK_T) E.midk(acc, cur, wr, wc, fr, fq); }
            const bool last = (t == nt - 2);
            const char* a1 = cA + (size_t)(t + 1) * kstep;
            const char* a2 = last ? nA : cA + (size_t)(t + 2) * kstep; const char* b2 = last ? nB : cB + (size_t)(t + 2) * kstep;
            const char* a3 = a2 + kstep; const char* b3 = b2 + kstep;
            if (last && has_next) S.a_ready(nxt);
            if constexpr (SP2) {
            PG8_LDB(B0, 0, 0); PG8_LDB(B1, 0, 1); PG8_SCHED; PG8_LDA(At, 0, 0); PG8_STAGE(PG8_SA(1, 1), a1 + hstep, voffA);
            PG8_WAIT_V(8); PG8_WAIT_L(0); PG8_BAR; PG8_MMA(0, 0, At, B0); PG8_MMA(0, 1, At, B1); PG8_BAR; PG8_SCHED;
            PG8_LDA(At, 0, 1); PG8_STAGE(PG8_SB(0, 0), b2, voffB); PG8_STAGE(PG8_SB(0, 1), b2 + hstep, voffB); PG8_STAGE(PG8_SA(0, 0), a2, voffA);
            PG8_WAIT_V(8); PG8_WAIT_L(0); PG8_BAR; PG8_MMA(1, 0, At, B0); PG8_MMA(1, 1, At, B1); PG8_BAR; PG8_SCHED;
            PG8_LDB(B0, 1, 0); PG8_LDB(B1, 1, 1); PG8_SCHED; PG8_LDA(At, 1, 0); PG8_STAGE(PG8_SA(0, 1), a2 + hstep, voffA);
            PG8_WAIT_V(8); PG8_WAIT_L(0); PG8_BAR; PG8_MMA(0, 0, At, B0); PG8_MMA(0, 1, At, B1); PG8_BAR; PG8_SCHED;
            PG8_LDA(At, 1, 1); PG8_STAGE(PG8_SB(1, 0), b3, voffB); PG8_STAGE(PG8_SB(1, 1), b3 + hstep, voffB); PG8_STAGE(PG8_SA(1, 0), a3, voffA);
            PG8_WAIT_V(8); PG8_WAIT_L(0); PG8_BAR; PG8_MMA(1, 0, At, B0); PG8_MMA(1, 1, At, B1); PG8_BAR; PG8_SCHED;
            } else {
            PG8_LDB(B0, 0, 0); PG8_SCHED; PG8_LDA(At, 0, 0); PG8_STAGE(PG8_SA(1, 1), a1 + hstep, voffA);
            PG8_WAIT_L(8); PG8_BAR; PG8_WAIT_L(0); PG8_MMA(0, 0, At, B0); PG8_BAR; PG8_SCHED;
            PG8_LDB(B1, 0, 1); PG8_STAGE(PG8_SB(0, 0), b2, voffB);
            PG8_BAR; PG8_WAIT_L(0); PG8_MMA(0, 1, At, B1); PG8_BAR;
            PG8_LDA(At, 0, 1); PG8_STAGE(PG8_SA(0, 0), a2, voffA);
            PG8_BAR; PG8_WAIT_L(0); PG8_MMA(1, 0, At, B0); PG8_BAR; PG8_SCHED;
            PG8_STAGE(PG8_SB(0, 1), b2 + hstep, voffB);
            PG8_WAIT_V(6); PG8_BAR; PG8_MMA(1, 1, At, B1); PG8_BAR;
            PG8_LDB(B0, 1, 0); PG8_SCHED; PG8_LDA(At, 1, 0); PG8_STAGE(PG8_SA(0, 1), a2 + hstep, voffA);
            PG8_WAIT_L(8); PG8_BAR; PG8_WAIT_L(0); PG8_MMA(0, 0, At, B0); PG8_BAR; PG8_SCHED;
            PG8_LDB(B1, 1, 1); PG8_STAGE(PG8_SB(1, 0), b3, voffB);
            PG8_BAR; PG8_WAIT_L(0); PG8_MMA(0, 1, At, B1); PG8_BAR;
            PG8_LDA(At, 1, 1); PG8_STAGE(PG8_SA(1, 0), a3, voffA);
            PG8_BAR; PG8_WAIT_L(0); PG8_MMA(1, 0, At, B0); PG8_BAR; PG8_SCHED;
            PG8_STAGE(PG8_SB(1, 1), b3 + hstep, voffB);
            PG8_WAIT_V(6); PG8_BAR; PG8_MMA(1, 1, At, B1); PG8_BAR;
            }
        }
        if constexpr (ALIGN_EPI) { if (wr == 0) PG8_BAR; }
        if constexpr (!Epi::AFTER_DRAIN) { E(acc, cur, wr, wc, fr, fq); S.done(cur); }
        if (!has_next) break;
#pragma unroll
        for (int a = 0; a < 2; ++a)
#pragma unroll
            for (int b = 0; b < 2; ++b)
#pragma unroll
                for (int m = 0; m < 4; ++m)
#pragma unroll
                    for (int n = 0; n < 2; ++n) acc[a][b][m][n] = (f32x4){0.f, 0.f, 0.f, 0.f};
        cur = nxt; cA = nA; cB = nB; ++ui;
        if constexpr (ALIGN_EPI) { if (wr == 1) PG8_BAR; }
    }
    PG8_WAIT_V(0);
    if constexpr (!ALIGN_EPI) { if (wr == 0) PG8_BAR; }
    PG8_BAR;
    if constexpr (Epi::AFTER_DRAIN) { E.fused(acc, cur, wr, wc, fr, fq, lds, wid, lane); S.done(cur); }
#undef PG8_SA
#undef PG8_SB
#undef PG8_STAGE
#undef PG8_LDA
#undef PG8_LDB
#undef PG8_MMA
#undef PG8_WAIT_V
#undef PG8_WAIT_L
#undef PG8_BAR
#undef PG8_SCHED
}
}

constexpr int NWAVES = 8;
constexpr int RING_OFF = 0, RING_BYTES = 131072;
constexpr int LDSCTL_OFF = RING_BYTES, MISC_OFF = LDSCTL_OFF + 320;
constexpr int LDS_BYTES = 147456;
#define GAS __attribute__((address_space(1)))
#define LAS __attribute__((address_space(3)))
typedef unsigned v4u __attribute__((ext_vector_type(4)));
typedef float f32x4 __attribute__((ext_vector_type(4)));
typedef short bf16x8 __attribute__((ext_vector_type(8)));
typedef GAS unsigned gu32;
#define RLX_AGENT __ATOMIC_RELAXED, __HIP_MEMORY_SCOPE_AGENT
#define LDS_WAIT() asm volatile("s_waitcnt lgkmcnt(0)" ::: "memory")
#define VM_WAIT() asm volatile("s_waitcnt vmcnt(0)" ::: "memory")

#define XB_TMO      128
#define XB_XCNT(j)  (256  + 64 * (j))
#define XB_XSUB(j)  (1280 + 64 * (j))
#define XB_XGEN(j)  (2304 + 64 * (j))
#define XB_TOP      3328
#define XB_TOPGEN   3392
#define XCD_BAR_WORDS 3456
#define XB_SPIN_CAP (1u << 18)

__device__ __forceinline__ unsigned xb_ld(unsigned* p)              { return __hip_atomic_load(p, __ATOMIC_RELAXED, __HIP_MEMORY_SCOPE_AGENT); }
__device__ __forceinline__ unsigned xb_add(unsigned* p, unsigned v) { return __hip_atomic_fetch_add(p, v, __ATOMIC_RELAXED, __HIP_MEMORY_SCOPE_AGENT); }
__device__ __forceinline__ unsigned xb_xcc_id() { return (unsigned)__builtin_amdgcn_s_getreg((3 << 11) | 20) & 0xFu; }
#define XB_SPIN(cond, bar) do { unsigned _sp = 0; while (cond) { __builtin_amdgcn_s_sleep(1); \
    if ((++_sp & 255u) == 0u) { if (xb_ld(&(bar)[XB_TMO])) break; if (_sp > XB_SPIN_CAP) { atomicAdd(&(bar)[XB_TMO], 1u); break; } } } } while (0)

struct XcdBarrier {
    unsigned* bar; unsigned x;
    volatile LAS unsigned* st;
};

__device__ __forceinline__ XcdBarrier xcd_barrier_post(unsigned* bar, volatile LAS unsigned* st) {
    XcdBarrier b; b.bar = bar; b.x = xb_xcc_id(); b.st = st;
    if (threadIdx.x == 0) (void)xb_add(&bar[XB_XCNT(b.x)], 1u);
    return b;
}
__device__ __forceinline__ void xcd_barrier_complete(unsigned* bar, unsigned x, unsigned& nloc, unsigned& nx) {
    const unsigned G = gridDim.x * gridDim.y * gridDim.z;
    unsigned sum, cnt, mine, sp = 0u;
    for (;;) {
        sum = 0u; cnt = 0u; mine = 0u;
#pragma unroll
        for (unsigned j = 0; j < 16; ++j) { const unsigned c = xb_ld(&bar[XB_XCNT(j)]); sum += c; cnt += (c > 0u) ? 1u : 0u; mine = (j == x) ? c : mine; }
        if (sum == G) break;
        __builtin_amdgcn_s_sleep(1);
        if ((++sp & 255u) == 0u) { if (xb_ld(&bar[XB_TMO])) break; if (sp > XB_SPIN_CAP) { atomicAdd(&bar[XB_TMO], 1u); break; } }
    }
    nloc = mine > 0u ? mine : 1u; nx = cnt > 0u ? cnt : 1u;
}

__device__ __forceinline__ void xcd_barrier(const XcdBarrier& b) {
    asm volatile("s_waitcnt vmcnt(0)" ::: "memory");
    __syncthreads();
    if (threadIdx.x == 0) {
        unsigned* bar = b.bar;
        __builtin_amdgcn_s_waitcnt(0);
        unsigned nloc = b.st[0], nx = b.st[1];
        if (nloc == 0u) { xcd_barrier_complete(bar, b.x, nloc, nx); b.st[0] = nloc; b.st[1] = nx; }
        const unsigned old = xb_add(&bar[XB_XSUB(b.x)], 1u);
        const unsigned gen = old / nloc;
        if (old + 1u == (gen + 1u) * nloc) {
            __builtin_amdgcn_fence(__ATOMIC_RELEASE, "agent");
            asm volatile("s_waitcnt vmcnt(0)" ::: "memory");
            const unsigned og = xb_add(&bar[XB_TOP], 1u);
            const unsigned tg = og / nx;
            if (og + 1u == (tg + 1u) * nx) xb_add(&bar[XB_TOPGEN], 1u);
            else XB_SPIN(xb_ld(&bar[XB_TOPGEN]) == tg, bar);
            __builtin_amdgcn_fence(__ATOMIC_ACQUIRE, "agent");
            xb_add(&bar[XB_XGEN(b.x)], 1u);
            asm volatile("s_waitcnt vmcnt(0)" ::: "memory");
        } else {
            XB_SPIN(xb_ld(&bar[XB_XGEN(b.x)]) == gen, bar);
            __builtin_amdgcn_fence(__ATOMIC_ACQUIRE, "agent");
            asm volatile("s_waitcnt vmcnt(0)" ::: "memory");
        }
    }
    __syncthreads();
}

struct Frame {
    LAS unsigned char* lds;
    volatile LAS unsigned* MISC;
    gu32* ctl;
    int tid, lane, wave;
    int vcu, G;
};

__device__ __forceinline__ float wave_sum(float v) {
#pragma unroll
    for (int o = 1; o < 64; o <<= 1) v += __shfl_xor(v, o);
    return v;
}

template <int MODE, int SCALE>
__device__ __forceinline__ void p0_transpose_item(const float* W, int K, int N, bf16_t* WT, LAS float* scr, int item, int lane) {
    const int nblk = N / 32, kb = item / nblk, nb = item % nblk, k0 = 64 * kb, n0 = 32 * nb;
#pragma unroll 8
    for (int i = 0; i < 32; ++i) { const int kk = 2 * i + (lane >> 5); scr[kk * 33 + (lane & 31)] = W[(size_t)(k0 + kk) * N + n0 + (lane & 31)]; }
    LDS_WAIT(); asm volatile("" ::: "memory");
    float sc = 1.f; if (SCALE) sc = (n0 < 1024) ? C_NA : ((n0 >= O_DAQ && n0 < O_DAK) ? C_DA : 1.f);
    const int row0 = MODE == 0 ? n0 : ((n0 >> 7) * 256 + (MODE == 2 ? 128 : 0) + (n0 & 127));
    const int c = lane & 7;
#pragma unroll
    for (int j = 0; j < 4; ++j) { const int n = (lane >> 3) + 8 * j; const LAS float* s = scr + (8 * c) * 33 + n;
        v4u o; o.x = pk2(s[0 * 33] * sc, s[1 * 33] * sc); o.y = pk2(s[2 * 33] * sc, s[3 * 33] * sc); o.z = pk2(s[4 * 33] * sc, s[5 * 33] * sc); o.w = pk2(s[6 * 33] * sc, s[7 * 33] * sc);
        *(GAS v4u*)(WT + (size_t)(row0 + n) * K + k0 + 8 * c) = o; }
    LDS_WAIT(); asm volatile("" ::: "memory");
}
__device__ __forceinline__ void p0_ada_task(const float* c, const float* w_ada, const float* b_ada, float* modacc, LAS float* scr, int t, int lane) {
    const int ng = t >> 5, kc = t & 31, n0 = ng * 256 + 4 * lane, k0 = kc * 64;
    float csv[4];
#pragma unroll
    for (int b = 0; b < 4; ++b) csv[b] = silu_f(c[b * D + k0 + lane]);
    f32x4 acc[4];
#pragma unroll
    for (int b = 0; b < 4; ++b) acc[b] = (f32x4){0.f, 0.f, 0.f, 0.f};
    const float* wp = w_ada + (size_t)k0 * (6 * D) + n0;
#pragma unroll 8
    for (int k = 0; k < 64; ++k) { const f32x4 w = *(const f32x4*)(wp + (size_t)k * (6 * D));
#pragma unroll
        for (int b = 0; b < 4; ++b) { const float s = __int_as_float(__builtin_amdgcn_readlane(__float_as_int(csv[b]), k)); acc[b] += w * s; } }
    if (kc == 0) { const f32x4 bb = *(const f32x4*)(b_ada + n0);
#pragma unroll
        for (int b = 0; b < 4; ++b) acc[b] += bb; }
#pragma unroll
    for (int b = 0; b < 4; ++b) *(LAS f32x4*)(scr + b * 256 + 4 * lane) = acc[b];
    LDS_WAIT(); asm volatile("" ::: "memory");
#pragma unroll
    for (int b = 0; b < 4; ++b)
#pragma unroll
        for (int j = 0; j < 4; ++j) atomicAdd(modacc + (size_t)b * 6 * D + ng * 256 + lane + 64 * j, scr[b * 256 + lane + 64 * j]);
    LDS_WAIT(); asm volatile("" ::: "memory");
}
struct P0Args { const float *c, *w_ada, *b_ada, *w_in, *w_out, *w_gate, *w_up, *w_down; float* modacc; bf16_t *Win_t, *Wout_t, *Wgu_t, *Wd_t; };
__device__ __forceinline__ void p0a_phase(Frame& F, const P0Args& a) {
    LAS float* scr = (LAS float*)(F.lds + RING_OFF + F.wave * 16384);
    if (F.wave < 6) { const int t = F.vcu * 6 + F.wave; if (t < 1536) p0_ada_task(a.c, a.w_ada, a.b_ada, a.modacc, scr, t, F.lane); }
    const int gw = F.vcu * NWAVES + F.wave, NGW = F.G * NWAVES;
    constexpr int I_IN = (D / 64) * (PW / 32), I_OUT = (D / 64) * (D / 32), I_G = (D / 64) * (DFF / 32), I_D = (DFF / 64) * (D / 32);
    constexpr int NITEMS = I_IN + I_OUT + 2 * I_G + I_D;
    for (int it = gw; it < NITEMS; it += NGW) {
        int r = it;
        if (r < I_IN) { p0_transpose_item<0, 1>(a.w_in, D, PW, a.Win_t, scr, r, F.lane); continue; } r -= I_IN;
        if (r < I_OUT) { p0_transpose_item<0, 0>(a.w_out, D, D, a.Wout_t, scr, r, F.lane); continue; } r -= I_OUT;
        if (r < I_G) { p0_transpose_item<1, 0>(a.w_gate, D, DFF, a.Wgu_t, scr, r, F.lane); continue; } r -= I_G;
        if (r < I_G) { p0_transpose_item<2, 0>(a.w_up, D, DFF, a.Wgu_t, scr, r, F.lane); continue; } r -= I_G;
        p0_transpose_item<0, 0>(a.w_down, DFF, D, a.Wd_t, scr, r, F.lane);
    }
}
__device__ __forceinline__ void p0b_phase(Frame& F, const float* x, const float* mod, const float* g1n, bf16_t* H, const bf16_t* Wgu_t, float* bgu) {
    const int gw = F.vcu * NWAVES + F.wave, NGW = F.G * NWAVES;
    for (int m = gw; m < M; m += NGW) {
        const int b = m / SEQ; const float* mb = mod + (size_t)b * 6 * D;
        const GAS f32x4* xr = (const GAS f32x4*)(x + (size_t)m * D) + F.lane;
        f32x4 v[8]; float s = 0.f;
#pragma unroll
        for (int j = 0; j < 8; ++j) { v[j] = xr[64 * j]; s += (v[j].x * v[j].x + v[j].y * v[j].y) + (v[j].z * v[j].z + v[j].w * v[j].w); }
        const float rstd = rsqrtf(wave_sum(s) * (1.f / D) + EPS);
        GAS unsigned long long* o8 = (GAS unsigned long long*)(H + (size_t)m * D) + F.lane;
#pragma unroll
        for (int j = 0; j < 8; ++j) { const int col = 4 * F.lane + 256 * j;
            const f32x4 sh = *(const f32x4*)(mb + col), sc = *(const f32x4*)(mb + D + col), gn = *(const f32x4*)(g1n + col);
            const f32x4 h = v[j] * rstd * gn * (sc + 1.0f) + sh;
            o8[64 * j] = (unsigned long long)pk2(h.x, h.y) | ((unsigned long long)pk2(h.z, h.w) << 32); }
    }
    LAS float* sh2s = (LAS float*)(F.lds + RING_OFF);
    for (int i = F.tid; i < 4 * D; i += NWAVES * 64) { const int b = i / D, k = i % D; sh2s[i] = mod[(size_t)b * 6 * D + 3 * D + k]; }
    __syncthreads();
    for (int nn = gw; nn < 2 * DFF; nn += NGW) {
        const int cc = nn < DFF ? nn : nn - DFF; const int row = (cc >> 7) * 256 + (nn < DFF ? 0 : 128) + (cc & 127);
        const GAS v4u* wr = (const GAS v4u*)(Wgu_t + (size_t)row * D) + F.lane;
        float a[4] = {0.f, 0.f, 0.f, 0.f};
#pragma unroll
        for (int j = 0; j < 4; ++j) { const v4u w = wr[64 * j]; const int k = 8 * (F.lane + 64 * j);
            float wf[8]; wf[0] = __uint_as_float(w.x << 16); wf[1] = __uint_as_float(w.x & 0xffff0000u); wf[2] = __uint_as_float(w.y << 16); wf[3] = __uint_as_float(w.y & 0xffff0000u);
            wf[4] = __uint_as_float(w.z << 16); wf[5] = __uint_as_float(w.z & 0xffff0000u); wf[6] = __uint_as_float(w.w << 16); wf[7] = __uint_as_float(w.w & 0xffff0000u);
#pragma unroll
            for (int b = 0; b < 4; ++b) { const f32x4 s0 = *(const LAS f32x4*)(sh2s + b * D + k), s1 = *(const LAS f32x4*)(sh2s + b * D + k + 4);
                a[b] += (wf[0] * s0.x + wf[1] * s0.y) + (wf[2] * s0.z + wf[3] * s0.w) + (wf[4] * s1.x + wf[5] * s1.y) + (wf[6] * s1.z + wf[7] * s1.w); } }
#pragma unroll
        for (int b = 0; b < 4; ++b) { const float t = wave_sum(a[b]); if (F.lane == 0) bgu[(size_t)b * 2 * DFF + nn] = t; }
    }
    __syncthreads();
}
__device__ __forceinline__ void p6_phase(Frame& F, float* out, const float* ss2, const float* fg) {
    const int gw = F.vcu * NWAVES + F.wave, NGW = F.G * NWAVES;
    for (int m = gw; m < M; m += NGW) {
        const float rstd = rsqrtf(ss2[m] * (1.f / D) + EPS);
        GAS f32x4* xr = (GAS f32x4*)(out + (size_t)m * D) + F.lane;
#pragma unroll
        for (int j = 0; j < 8; ++j) { const f32x4 gn = *(const f32x4*)(fg + 4 * F.lane + 256 * j); xr[64 * j] = xr[64 * j] * rstd * gn; }
    }
}

struct Args { const float* in[17]; float* out; unsigned char* ws; int ph_lo, ph_hi, li, pad; };
enum { PH_0A = 0, PH_0B = 1, PH_1 = 2, PH_2 = 3, PH_3 = 4, PH_4 = 5, PH_5 = 6, PH_6 = 7, PH_N = 8 };
__global__ void __launch_bounds__(NWAVES * 64, 2) mega(Args args) {
    extern __shared__ __attribute__((aligned(16))) unsigned char lds[];
    Frame F;
    F.lds = (LAS unsigned char*)lds;
    F.MISC = (volatile LAS unsigned*)(F.lds + MISC_OFF);
    F.tid = threadIdx.x; F.lane = F.tid & 63; F.wave = __builtin_amdgcn_readfirstlane(F.tid >> 6);
    F.G = gridDim.x; { const int bx = blockIdx.x; F.vcu = (F.G % 8 == 0) ? (bx % 8) * (F.G / 8) + bx / 8 : bx; }
    unsigned char* ws = args.ws;
    F.ctl = (gu32*)(ws + WS_CTL);
    const float* x = args.in[0]; const float* c = args.in[1]; const float* w_ada = args.in[2]; const float* b_ada = args.in[3];
    const float* norm1_g = args.in[4]; const float* w_in = args.in[5]; const float* w_out = args.in[11];
    const float* norm2_g = args.in[12]; const float* w_gate = args.in[13]; const float* w_up = args.in[14]; const float* w_down = args.in[15]; const float* final_g = args.in[16];
    float* mod = (float*)(ws + CTL_MOD); float* ssna = (float*)(ws + CTL_SSNA); float* ss1 = (float*)(ws + CTL_SS1); float* ss2 = (float*)(ws + CTL_SS2);
    float* bgu = (float*)(ws + WS_BGU);
    bf16_t* Win_t = (bf16_t*)(ws + WS_WIN); bf16_t* Wout_t = (bf16_t*)(ws + WS_WOUT); bf16_t* Wgu_t = (bf16_t*)(ws + WS_WGU); bf16_t* Wd_t = (bf16_t*)(ws + WS_WD);
    bf16_t* H = (bf16_t*)(ws + WS_H); bf16_t* AO = H; bf16_t* PROJ = (bf16_t*)(ws + WS_PROJ); bf16_t* ACT = PROJ;
    float* X1 = (float*)(ws + WS_X1); bf16_t* A2 = (bf16_t*)(ws + WS_A2);
    for (int u = F.tid; u < (LDS_BYTES - LDSCTL_OFF) / 4; u += NWAVES * 64) ((LAS unsigned*)(F.lds + LDSCTL_OFF))[u] = 0u;
    __syncthreads();
    XcdBarrier bar = xcd_barrier_post((unsigned*)(F.ctl + CW_BAR) + args.li * XCD_BAR_WORDS, F.MISC + 8);
    const int lo = args.ph_lo, hi = args.ph_hi;
#define IN(k) (lo <= (k) && (k) < hi)
#define SEAM(k) do { if (IN(k) && IN((k) + 1)) xcd_barrier(bar); } while (0)

    if (IN(PH_0A)) { P0Args a{c, w_ada, b_ada, w_in, w_out, w_gate, w_up, w_down, mod, Win_t, Wout_t, Wgu_t, Wd_t}; p0a_phase(F, a); __syncthreads(); }
    SEAM(PH_0A);
    if (IN(PH_0B)) { p0b_phase(F, x, mod, norm1_g, H, Wgu_t, bgu); }
    SEAM(PH_0B);
    if (IN(PH_1)) {
        pg8::Gemm g{H, Win_t, M, PW, D}; pg8::StaticOrder S; S.init(M, PW, F.G, (int)blockIdx.x);
        pg8::EpiProj E{PROJ};
        pg8::gemm_phase<pg8::EpiProj, pg8::StaticOrder, true, true>(F.lds + RING_OFF, g, S, E);
    }
    SEAM(PH_1);
    SEAM(PH_2);
    if (IN(PH_3)) {
        pg8::Gemm g{AO, Wout_t, M, D, D}; pg8::StaticOrder S; S.init(M, D, F.G, (int)blockIdx.x);
        pg8::EpiMix E{x, mod, norm2_g, ssna, X1, A2, ss1};
        pg8::gemm_phase<pg8::EpiMix, pg8::StaticOrder, true, true>(F.lds + RING_OFF, g, S, E);
    }
    SEAM(PH_3);
    if (IN(PH_4)) {
        pg8::Gemm g{A2, Wgu_t, M, 2 * DFF, D}; pg8::StaticOrder S; S.init(M, 2 * DFF, F.G, (int)blockIdx.x);
        pg8::EpiGU E{ss1, bgu, ACT};
        pg8::gemm_phase<pg8::EpiGU, pg8::StaticOrder, true, true>(F.lds + RING_OFF, g, S, E);
    }
    SEAM(PH_4);
    if (IN(PH_5)) {
        pg8::Gemm g{ACT, Wd_t, M, D, DFF}; pg8::StaticOrder S; S.init(M, D, F.G, (int)blockIdx.x);
        pg8::EpiDown E{X1, mod, args.out, ss2};
        pg8::gemm_phase<pg8::EpiDown, pg8::StaticOrder, true, true>(F.lds + RING_OFF, g, S, E);
    }
    SEAM(PH_5);
    if (IN(PH_6)) { p6_phase(F, args.out, ss2, final_g); }
#undef IN
#undef SEAM
}

__device__ __forceinline__ float block_sum(float v, float* red) {
    for (int o = 32; o > 0; o >>= 1) v += __shfl_xor(v, o);
    __syncthreads();
    if ((threadIdx.x & 63) == 0) red[threadIdx.x >> 6] = v;
    __syncthreads();
    float s = 0.f; for (int i = 0; i < (int)(blockDim.x >> 6); ++i) s += red[i];
    return s;
}
__device__ __forceinline__ float block_max(float v, float* red) {
    for (int o = 32; o > 0; o >>= 1) v = fmaxf(v, __shfl_xor(v, o));
    __syncthreads();
    if ((threadIdx.x & 63) == 0) red[threadIdx.x >> 6] = v;
    __syncthreads();
    float s = -INFINITY; for (int i = 0; i < (int)(blockDim.x >> 6); ++i) s = fmaxf(s, red[i]);
    return s;
}

__global__ __launch_bounds__(128) void n_na(const bf16_t* P, const float* rpb, const float* gout, bf16_t* AO, float* ssna) {
    __shared__ float q[128], p[128], red[64];
    const int m = blockIdx.x, h = blockIdx.y, t = threadIdx.x, b = m / SEQ, s = m % SEQ, r = s / 64, qc = s % 64;
    const int rs = min(max(r - 4, 0), 24), cs = min(max(qc - 8, 0), 48);
    q[t] = bf2f(P[(size_t)m * PW + O_NAQ + h * HD + t]);
    __syncthreads();
    const int jr = t >> 4, jc = t & 15, kr = rs + jr, kc = cs + jc; const size_t kt = (size_t)b * SEQ + kr * 64 + kc;
    const bf16_t* kp = P + kt * PW + O_NAK + h * HD;
    float sc = 0.f; for (int d = 0; d < HD; ++d) sc += q[d] * bf2f(kp[d]);
    sc += rpb[(h * 15 + (kr - r + 7)) * 31 + (kc - qc + 15)] * LOG2E;
    const float mx = block_max(sc, red); const float e = exp2f(sc - mx); const float l = block_sum(e, red);
    p[t] = e / l; __syncthreads();
    float o = 0.f;
    for (int j = 0; j < 128; ++j) { const size_t vt = (size_t)b * SEQ + (rs + (j >> 4)) * 64 + cs + (j & 15); o += p[j] * bf2f(P[vt * PW + O_NAV + h * HD + t]); }
    AO[(size_t)m * D + h * HD + t] = f2bf(o * gout[h * HD + t]);
    const float ss = block_sum(o * o, red); if (t == 0) atomicAdd(&ssna[m], ss);
}
__global__ __launch_bounds__(256) void n_da(const bf16_t* P, const float* t5, const float* lamp, const float* subg, bf16_t* AO) {
    __shared__ float q[128], s1[SEQ], s2[SEQ], red[64], oh[128];
    const int m = blockIdx.x, h = blockIdx.y, t = threadIdx.x, b = m / SEQ, s = m % SEQ;
    if (t < 128) q[t] = bf2f(P[(size_t)m * PW + O_DAQ + h * HD + t]);
    float lp = 0.f; if (t < 64) lp = lamp[t] * lamp[64 + t]; else if (t < 128) lp = -0.f + lamp[128 + (t - 64)] * lamp[192 + (t - 64)];
    __syncthreads();
    const float sA = block_sum(t < 64 ? lp : 0.f, red), sB = block_sum((t >= 64 && t < 128) ? lp : 0.f, red);
    const float lam = __expf(sA) - __expf(sB) + LAM_INIT;
    float m1 = -INFINITY, m2 = -INFINITY;
    for (int kk = t; kk < SEQ; kk += 256) { const bf16_t* kp = P + ((size_t)b * SEQ + kk) * PW + O_DAK + h * HD;
        float a = 0.f, c2 = 0.f;
        for (int d8 = 0; d8 < 8; ++d8) { const uint4 u = *(const uint4*)(kp + d8 * 8), w = *(const uint4*)(kp + 64 + d8 * 8);
            const unsigned uu[4] = {u.x, u.y, u.z, u.w}, ww[4] = {w.x, w.y, w.z, w.w};
            for (int e = 0; e < 4; ++e) { a += q[d8 * 8 + 2 * e] * __uint_as_float(uu[e] << 16) + q[d8 * 8 + 2 * e + 1] * __uint_as_float(uu[e] & 0xffff0000u);
                c2 += q[64 + d8 * 8 + 2 * e] * __uint_as_float(ww[e] << 16) + q[64 + d8 * 8 + 2 * e + 1] * __uint_as_float(ww[e] & 0xffff0000u); } }
        const float bias = t5[t5_bucket(kk - s) * NH + h] * LOG2E; a += bias; c2 += bias; s1[kk] = a; s2[kk] = c2; m1 = fmaxf(m1, a); m2 = fmaxf(m2, c2); }
    m1 = block_max(m1, red); m2 = block_max(m2, red);
    float l1 = 0.f, l2 = 0.f;
    for (int kk = t; kk < SEQ; kk += 256) { const float e1 = exp2f(s1[kk] - m1), e2 = exp2f(s2[kk] - m2); s1[kk] = e1; s2[kk] = e2; l1 += e1; l2 += e2; }
    l1 = block_sum(l1, red); l2 = block_sum(l2, red);
    __syncthreads();
    const int d = t & 127, part = t >> 7; float o = 0.f;
    for (int kk = part * 1024; kk < part * 1024 + 1024; ++kk) { const float a = s1[kk] / l1 - lam * (s2[kk] / l2); o += a * bf2f(P[((size_t)b * SEQ + kk) * PW + O_DAV + h * HD + d]); }
    if (part == 1) oh[d] = o; __syncthreads(); if (part == 0) o += oh[d];
    const float ss = block_sum(part == 0 ? o * o : 0.f, red);
    if (part == 0) AO[(size_t)m * D + 1024 + h * HD + d] = f2bf(o * rsqrtf(ss / HD + EPS) * subg[d] * (1.f - LAM_INIT));
}

extern "C" void kernel_launch(void* const* d_in, const int* in_sizes, int n_in, void* d_out, int out_size, void* d_ws, size_t ws_size, hipStream_t stream) {
    static int grid = 0;
    if (grid == 0) {
        if (n_in != 17 || out_size != M * D || ws_size < WS_END) { fprintf(stderr, "kernel_launch: unexpected shapes n_in %d out %d ws %zu\n", n_in, out_size, ws_size); grid = -1; return; }
        int dev = 0, cus = 0, per_cu = 0;
        if (hipGetDevice(&dev) != hipSuccess || hipDeviceGetAttribute(&cus, hipDeviceAttributeMultiprocessorCount, dev) != hipSuccess) { grid = -1; return; }
        if (hipFuncSetAttribute((const void*)mega, hipFuncAttributeMaxDynamicSharedMemorySize, LDS_BYTES) != hipSuccess) { fprintf(stderr, "kernel_launch: hipFuncSetAttribute failed\n"); grid = -1; return; }
        if (hipOccupancyMaxActiveBlocksPerMultiprocessor(&per_cu, (const void*)mega, NWAVES * 64, LDS_BYTES) != hipSuccess || per_cu < 1) { fprintf(stderr, "kernel_launch: occupancy query says %d\n", per_cu); per_cu = 1; }
        (void)hipGetLastError();
        grid = cus * (per_cu < 1 ? 1 : 1);
        if (grid != 256) fprintf(stderr, "kernel_launch: grid %d (expected 256)\n", grid);
    }
    if (grid < 0) return;
    char* ws = (char*)d_ws;
    (void)hipMemsetAsync(ws + WS_CTL, 0, CTL_BYTES, stream);
    Args a{};
    for (int i = 0; i < 17; ++i) a.in[i] = (const float*)d_in[i];
    a.out = (float*)d_out; a.ws = (unsigned char*)d_ws;
    float* ssna = (float*)(ws + CTL_SSNA); bf16_t* AO = (bf16_t*)(ws + WS_H); bf16_t* PROJ = (bf16_t*)(ws + WS_PROJ);
    a.ph_lo = PH_0A; a.ph_hi = PH_2; a.li = 0;
    hipLaunchKernelGGL(mega, dim3(grid), dim3(NWAVES * 64), LDS_BYTES, stream, a);
    n_na<<<dim3(M, NH), 128, 0, stream>>>(PROJ, (const float*)d_in[6], (const float*)d_in[7], AO, ssna);
    n_da<<<dim3(M, NH), 256, 0, stream>>>(PROJ, (const float*)d_in[10], (const float*)d_in[8], (const float*)d_in[9], AO);
    a.ph_lo = PH_3; a.ph_hi = PH_N; a.li = 1;
    hipLaunchKernelGGL(mega, dim3(grid), dim3(NWAVES * 64), LDS_BYTES, stream, a);
    const hipError_t le = hipPeekAtLastError();
    if (le != hipSuccess) fprintf(stderr, "kernel_launch: launch failed: %s\n", hipGetErrorName(le));
}
```

```cpp
#include <hip/hip_runtime.h>
#include <cstdio>
#include <cstdint>

typedef unsigned short bf16_t;
constexpr int BATCH = 4, SEQ = 2048, D = 2048, M = BATCH * SEQ;
constexpr int NH = 8, HD = 128, DQ = 64, PW = 6144, DFF = 5632;
constexpr int O_NAQ = 0, O_NAK = 1024, O_NAV = 2048, O_DAQ = 3072, O_DAK = 4096, O_DAV = 5120;
constexpr float EPS = 1e-6f;
constexpr float LOG2E = 1.4426950408889634f;
constexpr float C_NA = 0.08838834764831845f * LOG2E;
constexpr float C_DA = 0.125f * LOG2E;
constexpr float LAM_INIT = 0.2f;

constexpr size_t MiB = 1u << 20;
constexpr size_t WS_CTL = 0, CTL_BYTES = 1 * MiB;
constexpr int    CW_BAR = 4096;
constexpr size_t CTL_MOD = 128 * 1024;
constexpr size_t CTL_SSNA = 320 * 1024, CTL_SS1 = 352 * 1024, CTL_SS2 = 384 * 1024;
constexpr size_t WS_BGU = 1 * MiB;
constexpr size_t WS_WIN = 2 * MiB, WS_WOUT = 26 * MiB, WS_WGU = 34 * MiB, WS_WD = 78 * MiB;
constexpr size_t WS_H = 100 * MiB;
constexpr size_t WS_PROJ = 132 * MiB;
constexpr size_t WS_X1 = 228 * MiB;
constexpr size_t WS_A2 = 292 * MiB;
constexpr size_t WS_END = 324 * MiB;

__device__ __forceinline__ float bf2f(bf16_t v) { return __uint_as_float(((unsigned)v) << 16); }
__device__ __forceinline__ bf16_t f2bf(float f) { unsigned u = __float_as_uint(f); return (bf16_t)((u + 0x7fffu + ((u >> 16) & 1u)) >> 16); }
__device__ __forceinline__ unsigned pk2(float lo, float hi) { return (unsigned)f2bf(lo) | ((unsigned)f2bf(hi) << 16); }
__device__ __forceinline__ float silu_f(float v) { return v / (1.f + __expf(-v)); }
__device__ __forceinline__ float silu_fast(float v) { return v * __builtin_amdgcn_rcpf(1.f + __builtin_amdgcn_exp2f(-v * LOG2E)); }
__device__ __forceinline__ int t5_bucket(int rel) {
    const int n = rel < 0 ? -rel : rel; int b;
    if (n < 8) b = n; else if (n < 12) b = 8; else if (n < 16) b = 9; else if (n < 23) b = 10; else if (n < 32) b = 11;
    else if (n < 46) b = 12; else if (n < 64) b = 13; else if (n < 91) b = 14; else b = 15;
    return b + (rel > 0 ? 16 : 0);
}

namespace pg8 {
#define PG8_LAS __attribute__((address_space(3)))
typedef short bf16x8 __attribute__((ext_vector_type(8)));
typedef float f32x4 __attribute__((ext_vector_type(4)));
typedef unsigned u32x4 __attribute__((ext_vector_type(4)));
constexpr int BM = 256, BK = 64, HALF = 128, HTB = HALF * BK * 2  , STAGE_BYTES = 8 * HTB, NXCD = 8, WGM = 8;

__host__ __device__ __forceinline__ int lds_byte(int r, int c) { const int st = (r >> 4) * 2 + (c >> 5), rr = r & 15, cc = c & 31, ob = rr * 64 + cc * 2; return st * 1024 + (ob ^ (((ob >> 9) & 1) << 5)); }
__host__ __device__ __forceinline__ void stage_rc(int b, int& R, int& C) { const int st = b / 1024, sb = b % 1024, swz = sb ^ (((sb >> 9) & 1) << 5); R = (st >> 1) * 16 + swz / 64; C = (st & 1) * 32 + (swz % 64) / 2; }
__host__ __device__ __forceinline__ int perm32(int rho) { const int n = rho >> 4, i = rho & 15; return 8 * (i >> 2) + 4 * n + (i & 3); }

struct Unit { int pm, pn; };
struct Gemm { const bf16_t* A; const bf16_t* Bt; int M, N, K; };

struct StaticOrder {
    int nM, nN, nwg, G, c;
    __host__ __device__ void init(int M, int N, int G_, int c_) { nM = M / BM; nN = N / BM; nwg = nM * nN; G = G_; c = c_; }
    __host__ __device__ bool next(int i, Unit& u) const {
        const long L = (long)i * G + c; if (L >= nwg) return false;
        int wgid = (int)L; { const int q = nwg / NXCD, r = nwg % NXCD, xcd = wgid % NXCD, off = wgid / NXCD; wgid = (xcd < r ? xcd * (q + 1) : r * (q + 1) + (xcd - r) * q) + off; }
        const int nig = WGM * nN, gid = wgid / nig, fm = gid * WGM, gsz = (nM - fm) < WGM ? (nM - fm) : WGM;
        u.pm = fm + ((wgid % nig) % gsz); u.pn = (wgid % nig) / gsz; return true;
    }
    __device__ __forceinline__ void a_ready(const Unit&) const {}
    __device__ __forceinline__ void done(const Unit&) const {}
};
__device__ __forceinline__ unsigned cvt_pk_bf16(float lo, float hi) { unsigned r; asm volatile("v_cvt_pk_bf16_f32 %0, %1, %2" : "=v"(r) : "v"(lo), "v"(hi)); return r; }

struct EpiProj {
    static constexpr bool PERM = true, AFTER_DRAIN = false; static constexpr int MIDK_T = -1;
    bf16_t* O;
    __device__ __forceinline__ void midk(f32x4 (&)[2][2][4][2], const Unit&, int, int, int, int) const {}
    __device__ __forceinline__ void operator()(const f32x4 (&acc)[2][2][4][2], const Unit& u, int wr, int wc, int fr, int fq) const {
        const int row0 = u.pm * BM + wr * 64 + fr, col0 = u.pn * BM + wc * 32 + 8 * fq;
#pragma unroll
        for (int ai = 0; ai < 2; ++ai)
#pragma unroll
            for (int m = 0; m < 4; ++m) { bf16_t* rowp = O + (size_t)(row0 + ai * HALF + m * 16) * PW + col0;
#pragma unroll
                for (int bj = 0; bj < 2; ++bj) { const f32x4 v0 = acc[ai][bj][m][0], v1 = acc[ai][bj][m][1];
                    u32x4 w; w.x = cvt_pk_bf16(v0[0], v0[1]); w.y = cvt_pk_bf16(v0[2], v0[3]); w.z = cvt_pk_bf16(v1[0], v1[1]); w.w = cvt_pk_bf16(v1[2], v1[3]);
                    *(u32x4*)(rowp + bj * HALF) = w; } }
    }
};
struct EpiMix {
    static constexpr bool PERM = true, AFTER_DRAIN = false; static constexpr int MIDK_T = 16;
    const float* x; const float* mod; const float* g2n; const float* ssna; float* X1; bf16_t* A2; float* ss1;
    __device__ __forceinline__ void midk(f32x4 (&acc)[2][2][4][2], const Unit& u, int wr, int wc, int fr, int fq) const {
        const int row0 = u.pm * BM + wr * 64 + fr;
#pragma unroll
        for (int ai = 0; ai < 2; ++ai)
#pragma unroll
            for (int m = 0; m < 4; ++m) { const float r = rsqrtf(ssna[row0 + ai * HALF + m * 16] * (1.f / 1024.f) + EPS);
#pragma unroll
                for (int bj = 0; bj < 2; ++bj)
#pragma unroll
                    for (int n = 0; n < 2; ++n) acc[ai][bj][m][n] *= r; }
    }
    __device__ __forceinline__ void operator()(const f32x4 (&acc)[2][2][4][2], const Unit& u, int wr, int wc, int fr, int fq) const {
        const int row0 = u.pm * BM + wr * 64 + fr, col0 = u.pn * BM + wc * 32 + 8 * fq, b = u.pm >> 3;
        const float* mb = mod + (size_t)b * 6 * D;
        f32x4 g1v[2][2], gmv[2][2];
#pragma unroll
        for (int bj = 0; bj < 2; ++bj)
#pragma unroll
            for (int n = 0; n < 2; ++n) { const int c = col0 + bj * HALF + 4 * n; g1v[bj][n] = *(const f32x4*)(mb + 2 * D + c);
                const f32x4 sc = *(const f32x4*)(mb + 4 * D + c), gn = *(const f32x4*)(g2n + c); gmv[bj][n] = gn * (sc + 1.0f); }
#pragma unroll
        for (int ai = 0; ai < 2; ++ai)
#pragma unroll
            for (int m = 0; m < 4; ++m) { const int row = row0 + ai * HALF + m * 16; const size_t off = (size_t)row * D + col0; float ss = 0.f;
#pragma unroll
                for (int bj = 0; bj < 2; ++bj) { f32x4 x1[2];
#pragma unroll
                    for (int n = 0; n < 2; ++n) { const f32x4 xv = *(const f32x4*)(x + off + bj * HALF + 4 * n); x1[n] = xv + g1v[bj][n] * acc[ai][bj][m][n];
                        *(f32x4*)(X1 + off + bj * HALF + 4 * n) = x1[n]; ss += (x1[n][0] * x1[n][0] + x1[n][1] * x1[n][1]) + (x1[n][2] * x1[n][2] + x1[n][3] * x1[n][3]); }
                    const f32x4 a0 = x1[0] * gmv[bj][0], a1 = x1[1] * gmv[bj][1];
                    u32x4 w; w.x = cvt_pk_bf16(a0[0], a0[1]); w.y = cvt_pk_bf16(a0[2], a0[3]); w.z = cvt_pk_bf16(a1[0], a1[1]); w.w = cvt_pk_bf16(a1[2], a1[3]);
                    *(u32x4*)(A2 + off + bj * HALF) = w; }
                ss += __shfl_xor(ss, 16); ss += __shfl_xor(ss, 32);
                if (fq == 0) atomicAdd(ss1 + row, ss); }
    }
};
struct EpiGU {
    static constexpr bool PERM = true, AFTER_DRAIN = false; static constexpr int MIDK_T = -1;
    const float* ss1; const float* bgu; bf16_t* ACT;
    __device__ __forceinline__ void midk(f32x4 (&)[2][2][4][2], const Unit&, int, int, int, int) const {}
    __device__ __forceinline__ void operator()(const f32x4 (&acc)[2][2][4][2], const Unit& u, int wr, int wc, int fr, int fq) const {
        const int row0 = u.pm * BM + wr * 64 + fr, colo = u.pn * HALF + wc * 32 + 8 * fq, b = u.pm >> 3;
        const float* bb = bgu + (size_t)b * 2 * DFF;
        f32x4 bg[2], bu[2];
#pragma unroll
        for (int n = 0; n < 2; ++n) { bg[n] = *(const f32x4*)(bb + colo + 4 * n); bu[n] = *(const f32x4*)(bb + DFF + colo + 4 * n); }
#pragma unroll
        for (int ai = 0; ai < 2; ++ai)
#pragma unroll
            for (int m = 0; m < 4; ++m) { const int row = row0 + ai * HALF + m * 16; const float rstd = rsqrtf(ss1[row] * (1.f / D) + EPS);
                float o[8];
#pragma unroll
                for (int n = 0; n < 2; ++n) { const f32x4 g = acc[ai][0][m][n] * rstd + bg[n], uu = acc[ai][1][m][n] * rstd + bu[n];
#pragma unroll
                    for (int j = 0; j < 4; ++j) o[4 * n + j] = silu_fast(g[j]) * uu[j]; }
                u32x4 w; w.x = cvt_pk_bf16(o[0], o[1]); w.y = cvt_pk_bf16(o[2], o[3]); w.z = cvt_pk_bf16(o[4], o[5]); w.w = cvt_pk_bf16(o[6], o[7]);
                *(u32x4*)(ACT + (size_t)row * DFF + colo) = w; }
    }
};
struct EpiDown {
    static constexpr bool PERM = true, AFTER_DRAIN = false; static constexpr int MIDK_T = -1;
    const float* X1; const float* mod; float* X2; float* ss2;
    __device__ __forceinline__ void midk(f32x4 (&)[2][2][4][2], const Unit&, int, int, int, int) const {}
    __device__ __forceinline__ void operator()(const f32x4 (&acc)[2][2][4][2], const Unit& u, int wr, int wc, int fr, int fq) const {
        const int row0 = u.pm * BM + wr * 64 + fr, col0 = u.pn * BM + wc * 32 + 8 * fq, b = u.pm >> 3;
        const float* mb = mod + (size_t)b * 6 * D + 5 * D;
        f32x4 g2v[2][2];
#pragma unroll
        for (int bj = 0; bj < 2; ++bj)
#pragma unroll
            for (int n = 0; n < 2; ++n) g2v[bj][n] = *(const f32x4*)(mb + col0 + bj * HALF + 4 * n);
#pragma unroll
        for (int ai = 0; ai < 2; ++ai)
#pragma unroll
            for (int m = 0; m < 4; ++m) { const int row = row0 + ai * HALF + m * 16; const size_t off = (size_t)row * D + col0; float ss = 0.f;
#pragma unroll
                for (int bj = 0; bj < 2; ++bj)
#pragma unroll
                    for (int n = 0; n < 2; ++n) { const f32x4 xv = *(const f32x4*)(X1 + off + bj * HALF + 4 * n); const f32x4 x2 = xv + g2v[bj][n] * acc[ai][bj][m][n];
                        *(f32x4*)(X2 + off + bj * HALF + 4 * n) = x2; ss += (x2[0] * x2[0] + x2[1] * x2[1]) + (x2[2] * x2[2] + x2[3] * x2[3]); }
                ss += __shfl_xor(ss, 16); ss += __shfl_xor(ss, 32);
                if (fq == 0) atomicAdd(ss2 + row, ss); }
    }
};

template <class Epi, class Sched, bool ALIGN_EPI = false, bool SP2 = false>
__device__ __forceinline__ void gemm_phase(PG8_LAS unsigned char* lds, const Gemm g, const Sched& S, const Epi& E) {
    const int tid = threadIdx.x, wid = __builtin_amdgcn_readfirstlane(tid >> 6), lane = tid & 63, wr = wid >> 2, wc = wid & 3, fr = lane & 15, fq = lane >> 4;
    const int K = g.K, nt = K / BK;
    unsigned voffA[2], voffB[2];
#pragma unroll
    for (int i = 0; i < 2; ++i) { int R, C; stage_rc(tid * 16 + i * 8192, R, C); const int Rb = Epi::PERM ? ((R & ~31) + perm32(R & 31)) : R;
        voffA[i] = (unsigned)(R * K + C) * 2u; voffB[i] = (unsigned)(Rb * K + C) * 2u; }
    const size_t kstep = (size_t)(BK * 2);
    const size_t hstep = (size_t)HALF * K * 2;
    const size_t tstep = 2 * hstep;
    const unsigned ldsw = (unsigned)wid * 1024u;
    const int aoff = lds_byte(wr * 64 + fr, fq * 8), boff = lds_byte(wc * 32 + fr, fq * 8);
#define PG8_SA(b, h) (((b) * 2 + (h)) * HTB)
#define PG8_SB(b, h) ((4 + (b) * 2 + (h)) * HTB)
#define PG8_STAGE(bufoff, gbase, voff) do { _Pragma("unroll") for (int _i = 0; _i < 2; ++_i) \
        __builtin_amdgcn_global_load_lds((const unsigned*)((const char*)(gbase) + (voff)[_i]), (PG8_LAS unsigned*)(lds + (bufoff) + ldsw + _i * 8192), 16, 0, 0); } while (0)
#define PG8_LDA(dst, b, h) do { _Pragma("unroll") for (int m = 0; m < 4; ++m) _Pragma("unroll") for (int k = 0; k < 2; ++k) dst[m][k] = *(const PG8_LAS bf16x8*)(lds + PG8_SA(b, h) + aoff + m * 2048 + k * 1024); } while (0)
#define PG8_LDB(dst, b, h) do { _Pragma("unroll") for (int n = 0; n < 2; ++n) _Pragma("unroll") for (int k = 0; k < 2; ++k) dst[n][k] = *(const PG8_LAS bf16x8*)(lds + PG8_SB(b, h) + boff + n * 2048 + k * 1024); } while (0)
#define PG8_MMA(ai, bj, At, Bt) do { __builtin_amdgcn_s_setprio(1); _Pragma("unroll") for (int m = 0; m < 4; ++m) _Pragma("unroll") for (int n = 0; n < 2; ++n) _Pragma("unroll") for (int k = 0; k < 2; ++k) \
        acc[ai][bj][m][n] = __builtin_amdgcn_mfma_f32_16x16x32_bf16(Bt[n][k], At[m][k], acc[ai][bj][m][n], 0, 0, 0); __builtin_amdgcn_s_setprio(0); } while (0)
#define PG8_WAIT_V(n) asm volatile("s_waitcnt vmcnt(" #n ")" ::: "memory")
#define PG8_WAIT_L(n) asm volatile("s_waitcnt lgkmcnt(" #n ")" ::: "memory")
#define PG8_BAR __builtin_amdgcn_s_barrier()
#define PG8_SCHED __builtin_amdgcn_sched_barrier(0)
    Unit cur, nxt; int ui = 0;
    if (!S.next(0, cur)) return;
    f32x4 acc[2][2][4][2];
#pragma unroll
    for (int a = 0; a < 2; ++a)
#pragma unroll
        for (int b = 0; b < 2; ++b)
#pragma unroll
            for (int m = 0; m < 4; ++m)
#pragma unroll
                for (int n = 0; n < 2; ++n) acc[a][b][m][n] = (f32x4){0.f, 0.f, 0.f, 0.f};
    bf16x8 At[4][2], B0[2][2], B1[2][2];
    const char* cA = (const char*)g.A + (size_t)cur.pm * tstep; const char* cB = (const char*)g.Bt + (size_t)cur.pn * tstep;
    S.a_ready(cur);
    if constexpr (SP2) {
        PG8_STAGE(PG8_SB(0, 0), cB, voffB); PG8_STAGE(PG8_SB(0, 1), cB + hstep, voffB); PG8_STAGE(PG8_SA(0, 0), cA, voffA); PG8_STAGE(PG8_SA(0, 1), cA + hstep, voffA);
        if (wr == 1) PG8_BAR;
        PG8_WAIT_V(2); PG8_BAR;
        PG8_STAGE(PG8_SB(1, 0), cB + kstep, voffB); PG8_STAGE(PG8_SA(1, 0), cA + kstep, voffA); PG8_STAGE(PG8_SB(1, 1), cB + hstep + kstep, voffB);
        PG8_WAIT_V(6); PG8_BAR;
    } else {
        PG8_STAGE(PG8_SB(0, 0), cB, voffB); PG8_STAGE(PG8_SA(0, 0), cA, voffA); PG8_STAGE(PG8_SB(0, 1), cB + hstep, voffB); PG8_STAGE(PG8_SA(0, 1), cA + hstep, voffA);
        if (wr == 1) PG8_BAR;
        PG8_WAIT_V(4); PG8_BAR;
        PG8_STAGE(PG8_SB(1, 0), cB + kstep, voffB); PG8_STAGE(PG8_SA(1, 0), cA + kstep, voffA); PG8_STAGE(PG8_SB(1, 1), cB + hstep + kstep, voffB);
        PG8_WAIT_V(6); PG8_BAR;
    }
    for (;;) {
        const bool has_next = S.next(ui + 1, nxt);
        const char* nA = has_next ? (const char*)g.A + (size_t)nxt.pm * tstep : cA; const char* nB = has_next ? (const char*)g.Bt + (size_t)nxt.pn * tstep : cB;
        for (int t = 0; t < nt; t += 2) {
            if constexpr (Epi::MIDK_T >= 0) { if (t == Epi::MIDK_T) E.midk(acc, cur, wr, wc, fr, fq); }
            const bool last = (t == nt - 2);
            const char* a1 = cA + (size_t)(t + 1) * kstep;
            const char* a2 = last ? nA : cA + (size_t)(t + 2) * kstep; const char* b2 = last ? nB : cB + (size_t)(t + 2) * kstep;
            const char* a3 = a2 + kstep; const char* b3 = b2 + kstep;
            if (last && has_next) S.a_ready(nxt);
            if constexpr (SP2) {
            PG8_LDB(B0, 0, 0); PG8_LDB(B1, 0, 1); PG8_SCHED; PG8_LDA(At, 0, 0); PG8_STAGE(PG8_SA(1, 1), a1 + hstep, voffA);
            PG8_WAIT_V(8); PG8_WAIT_L(0); PG8_BAR; PG8_MMA(0, 0, At, B0); PG8_MMA(0, 1, At, B1); PG8_BAR; PG8_SCHED;
            PG8_LDA(At, 0, 1); PG8_STAGE(PG8_SB(0, 0), b2, voffB); PG8_STAGE(PG8_SB(0, 1), b2 + hstep, voffB); PG8_STAGE(PG8_SA(0, 0), a2, voffA);
            PG8_WAIT_V(8); PG8_WAIT_L(0); PG8_BAR; PG8_MMA(1, 0, At, B0); PG8_MMA(1, 1, At, B1); PG8_BAR; PG8_SCHED;
            PG8_LDB(B0, 1, 0); PG8_LDB(B1, 1, 1); PG8_SCHED; PG8_LDA(At, 1, 0); PG8_STAGE(PG8_SA(0, 1), a2 + hstep, voffA);
            PG8_WAIT_V(8); PG8_WAIT_L(0); PG8_BAR; PG8_MMA(0, 0, At, B0); PG8_MMA(0, 1, At, B1); PG8_BAR; PG8_SCHED;
            PG8_LDA(At, 1, 1); PG8_STAGE(PG8_SB(1, 0), b3, voffB); PG8_STAGE(PG8_SB(1, 1), b3 + hstep, voffB); PG8_STAGE(PG8_SA(1, 0), a3, voffA);
            PG8_WAIT_V(8); PG8_WAIT_L(0); PG8_BAR; PG8_MMA(1, 0, At, B0); PG8_MMA(1, 1, At, B1); PG8_BAR; PG8_SCHED;
            } else {
            PG8_LDB(B0, 0, 0); PG8_SCHED; PG8_LDA(At, 0, 0); PG8_STAGE(PG8_SA(1, 1), a1 + hstep, voffA);
            PG8_WAIT_L(8); PG8_BAR; PG8_WAIT_L(0); PG8_MMA(0, 0, At, B0); PG8_BAR; PG8_SCHED;
            PG8_LDB(B1, 0, 1); PG8_STAGE(PG8_SB(0, 0), b2, voffB);
            PG8_BAR; PG8_WAIT_L(0); PG8_MMA(0, 1, At, B1); PG8_BAR;
            PG8_LDA(At, 0, 1); PG8_STAGE(PG8_SA(0, 0), a2, voffA);
            PG8_BAR; PG8_WAIT_L(0); PG8_MMA(1, 0, At, B0); PG8_BAR; PG8_SCHED;
            PG8_STAGE(PG8_SB(0, 1), b2 + hstep, voffB);
            PG8_WAIT_V(6); PG8_BAR; PG8_MMA(1, 1, At, B1); PG8_BAR;
            PG8_LDB(B0, 1, 0); PG8_SCHED; PG8_LDA(At, 1, 0); PG8_STAGE(PG8_SA(0, 1), a2 + hstep, voffA);
            PG8_WAIT_L(8); PG8_BAR; PG8_WAIT_L(0); PG8_MMA(0, 0, At, B0); PG8_BAR; PG8_SCHED;
            PG8_LDB(B1, 1, 1); PG8_STAGE(PG8_SB(1, 0), b3, voffB);
            PG8_BAR; PG8_WAIT_L(0); PG8_MMA(0, 1, At, B1); PG8_BAR;
            PG8_LDA(At, 1, 1); PG8_STAGE(PG8_SA(1, 0), a3, voffA);
            PG8_BAR; PG8_WAIT_L(0); PG8_MMA(1, 0, At, B0); PG8_BAR; PG8_SCHED;
            PG8_STAGE(PG8_SB(1, 1), b3 + hstep, voffB);
            PG8_WAIT_V(6); PG8_BAR; PG8_MMA(1, 1, At, B1); PG8_BAR;
            }
        }
        if constexpr (ALIGN_EPI) { if (wr == 0) PG8_BAR; }
        if constexpr (!Epi::AFTER_DRAIN) { E(acc, cur, wr, wc, fr, fq); S.done(cur); }
        if (!has_next) break;
#pragma unroll
        for (int a = 0; a < 2; ++a)
#pragma unroll
            for (int b = 0; b < 2; ++b)
#pragma unroll
                for (int m = 0; m < 4; ++m)
#pragma unroll
                    for (int n = 0; n < 2; ++n) acc[a][b][m][n] = (f32x4){0.f, 0.f, 0.f, 0.f};
        cur = nxt; cA = nA; cB = nB; ++ui;
        if constexpr (ALIGN_EPI) { if (wr == 1) PG8_BAR; }
    }
    PG8_WAIT_V(0);
    if constexpr (!ALIGN_EPI) { if (wr == 0) PG8_BAR; }
    PG8_BAR;
    if constexpr (Epi::AFTER_DRAIN) { E.fused(acc, cur, wr, wc, fr, fq, lds, wid, lane); S.done(cur); }
#undef PG8_SA
#undef PG8_SB
#undef PG8_STAGE
#undef PG8_LDA
#undef PG8_LDB
#undef PG8_MMA
#undef PG8_WAIT_V
#undef PG8_WAIT_L
#undef PG8_BAR
#undef PG8_SCHED
}
}

constexpr int NWAVES = 8;
constexpr int RING_OFF = 0, RING_BYTES = 131072;
constexpr int LDSCTL_OFF = RING_BYTES, MISC_OFF = LDSCTL_OFF + 320;
constexpr int LDS_BYTES = 147456;
#define GAS __attribute__((address_space(1)))
#define LAS __attribute__((address_space(3)))
typedef unsigned v4u __attribute__((ext_vector_type(4)));
typedef float f32x4 __attribute__((ext_vector_type(4)));
typedef short bf16x8 __attribute__((ext_vector_type(8)));
typedef GAS unsigned gu32;
#define RLX_AGENT __ATOMIC_RELAXED, __HIP_MEMORY_SCOPE_AGENT
#define LDS_WAIT() asm volatile("s_waitcnt lgkmcnt(0)" ::: "memory")
#define VM_WAIT() asm volatile("s_waitcnt vmcnt(0)" ::: "memory")

#define XB_TMO      128
#define XB_XCNT(j)  (256  + 64 * (j))
#define XB_XSUB(j)  (1280 + 64 * (j))
#define XB_XGEN(j)  (2304 + 64 * (j))
#define XB_TOP      3328
#define XB_TOPGEN   3392
#define XCD_BAR_WORDS 3456
#define XB_SPIN_CAP (1u << 18)

__device__ __forceinline__ unsigned xb_ld(unsigned* p)              { return __hip_atomic_load(p, __ATOMIC_RELAXED, __HIP_MEMORY_SCOPE_AGENT); }
__device__ __forceinline__ unsigned xb_add(unsigned* p, unsigned v) { return __hip_atomic_fetch_add(p, v, __ATOMIC_RELAXED, __HIP_MEMORY_SCOPE_AGENT); }
__device__ __forceinline__ unsigned xb_xcc_id() { return (unsigned)__builtin_amdgcn_s_getreg((3 << 11) | 20) & 0xFu; }
#define XB_SPIN(cond, bar) do { unsigned _sp = 0; while (cond) { __builtin_amdgcn_s_sleep(1); \
    if ((++_sp & 255u) == 0u) { if (xb_ld(&(bar)[XB_TMO])) break; if (_sp > XB_SPIN_CAP) { atomicAdd(&(bar)[XB_TMO], 1u); break; } } } } while (0)

struct XcdBarrier {
    unsigned* bar; unsigned x;
    volatile LAS unsigned* st;
};

__device__ __forceinline__ XcdBarrier xcd_barrier_post(unsigned* bar, volatile LAS unsigned* st) {
    XcdBarrier b; b.bar = bar; b.x = xb_xcc_id(); b.st = st;
    if (threadIdx.x == 0) (void)xb_add(&bar[XB_XCNT(b.x)], 1u);
    return b;
}
__device__ __forceinline__ void xcd_barrier_complete(unsigned* bar, unsigned x, unsigned& nloc, unsigned& nx) {
    const unsigned G = gridDim.x * gridDim.y * gridDim.z;
    unsigned sum, cnt, mine, sp = 0u;
    for (;;) {
        sum = 0u; cnt = 0u; mine = 0u;
#pragma unroll
        for (unsigned j = 0; j < 16; ++j) { const unsigned c = xb_ld(&bar[XB_XCNT(j)]); sum += c; cnt += (c > 0u) ? 1u : 0u; mine = (j == x) ? c : mine; }
        if (sum == G) break;
        __builtin_amdgcn_s_sleep(1);
        if ((++sp & 255u) == 0u) { if (xb_ld(&bar[XB_TMO])) break; if (sp > XB_SPIN_CAP) { atomicAdd(&bar[XB_TMO], 1u); break; } }
    }
    nloc = mine > 0u ? mine : 1u; nx = cnt > 0u ? cnt : 1u;
}

__device__ __forceinline__ void xcd_barrier(const XcdBarrier& b) {
    asm volatile("s_waitcnt vmcnt(0)" ::: "memory");
    __syncthreads();
    if (threadIdx.x == 0) {
        unsigned* bar = b.bar;
        __builtin_amdgcn_s_waitcnt(0);
        unsigned nloc = b.st[0], nx = b.st[1];
        if (nloc == 0u) { xcd_barrier_complete(bar, b.x, nloc, nx); b.st[0] = nloc; b.st[1] = nx; }
        const unsigned old = xb_add(&bar[XB_XSUB(b.x)], 1u);
        const unsigned gen = old / nloc;
        if (old + 1u == (gen + 1u) * nloc) {
            __builtin_amdgcn_fence(__ATOMIC_RELEASE, "agent");
            asm volatile("s_waitcnt vmcnt(0)" ::: "memory");
            const unsigned og = xb_add(&bar[XB_TOP], 1u);
            const unsigned tg = og / nx;
            if (og + 1u == (tg + 1u) * nx) xb_add(&bar[XB_TOPGEN], 1u);
            else XB_SPIN(xb_ld(&bar[XB_TOPGEN]) == tg, bar);
            __builtin_amdgcn_fence(__ATOMIC_ACQUIRE, "agent");
            xb_add(&bar[XB_XGEN(b.x)], 1u);
            asm volatile("s_waitcnt vmcnt(0)" ::: "memory");
        } else {
            XB_SPIN(xb_ld(&bar[XB_XGEN(b.x)]) == gen, bar);
            __builtin_amdgcn_fence(__ATOMIC_ACQUIRE, "agent");
            asm volatile("s_waitcnt vmcnt(0)" ::: "memory");
        }
    }
    __syncthreads();
}

struct Frame {
    LAS unsigned char* lds;
    volatile LAS unsigned* MISC;
    gu32* ctl;
    int tid, lane, wave;
    int vcu, G;
};

__device__ __forceinline__ float wave_sum(float v) {
#pragma unroll
    for (int o = 1; o < 64; o <<= 1) v += __shfl_xor(v, o);
    return v;
}

template <int MODE, int SCALE>
__device__ __forceinline__ void p0_transpose_item(const float* W, int K, int N, bf16_t* WT, LAS float* scr, int item, int lane) {
    const int nblk = N / 32, kb = item / nblk, nb = item % nblk, k0 = 64 * kb, n0 = 32 * nb;
#pragma unroll 8
    for (int i = 0; i < 32; ++i) { const int kk = 2 * i + (lane >> 5); scr[kk * 33 + (lane & 31)] = W[(size_t)(k0 + kk) * N + n0 + (lane & 31)]; }
    LDS_WAIT(); asm volatile("" ::: "memory");
    float sc = 1.f; if (SCALE) sc = (n0 < 1024) ? C_NA : ((n0 >= O_DAQ && n0 < O_DAK) ? C_DA : 1.f);
    const int row0 = MODE == 0 ? n0 : ((n0 >> 7) * 256 + (MODE == 2 ? 128 : 0) + (n0 & 127));
    const int c = lane & 7;
#pragma unroll
    for (int j = 0; j < 4; ++j) { const int n = (lane >> 3) + 8 * j; const LAS float* s = scr + (8 * c) * 33 + n;
        v4u o; o.x = pk2(s[0 * 33] * sc, s[1 * 33] * sc); o.y = pk2(s[2 * 33] * sc, s[3 * 33] * sc); o.z = pk2(s[4 * 33] * sc, s[5 * 33] * sc); o.w = pk2(s[6 * 33] * sc, s[7 * 33] * sc);
        *(GAS v4u*)(WT + (size_t)(row0 + n) * K + k0 + 8 * c) = o; }
    LDS_WAIT(); asm volatile("" ::: "memory");
}
__device__ __forceinline__ void p0_ada_task(const float* c, const float* w_ada, const float* b_ada, float* modacc, LAS float* scr, int t, int lane) {
    const int ng = t >> 5, kc = t & 31, n0 = ng * 256 + 4 * lane, k0 = kc * 64;
    float csv[4];
#pragma unroll
    for (int b = 0; b < 4; ++b) csv[b] = silu_f(c[b * D + k0 + lane]);
    f32x4 acc[4];
#pragma unroll
    for (int b = 0; b < 4; ++b) acc[b] = (f32x4){0.f, 0.f, 0.f, 0.f};
    const float* wp = w_ada + (size_t)k0 * (6 * D) + n0;
#pragma unroll 8
    for (int k = 0; k < 64; ++k) { const f32x4 w = *(const f32x4*)(wp + (size_t)k * (6 * D));
#pragma unroll
        for (int b = 0; b < 4; ++b) { const float s = __int_as_float(__builtin_amdgcn_readlane(__float_as_int(csv[b]), k)); acc[b] += w * s; } }
    if (kc == 0) { const f32x4 bb = *(const f32x4*)(b_ada + n0);
#pragma unroll
        for (int b = 0; b < 4; ++b) acc[b] += bb; }
#pragma unroll
    for (int b = 0; b < 4; ++b) *(LAS f32x4*)(scr + b * 256 + 4 * lane) = acc[b];
    LDS_WAIT(); asm volatile("" ::: "memory");
#pragma unroll
    for (int b = 0; b < 4; ++b)
#pragma unroll
        for (int j = 0; j < 4; ++j) atomicAdd(modacc + (size_t)b * 6 * D + ng * 256 + lane + 64 * j, scr[b * 256 + lane + 64 * j]);
    LDS_WAIT(); asm volatile("" ::: "memory");
}
struct P0Args { const float *c, *w_ada, *b_ada, *w_in, *w_out, *w_gate, *w_up, *w_down; float* modacc; bf16_t *Win_t, *Wout_t, *Wgu_t, *Wd_t; };
__device__ __forceinline__ void p0a_phase(Frame& F, const P0Args& a) {
    LAS float* scr = (LAS float*)(F.lds + RING_OFF + F.wave * 16384);
    if (F.wave < 6) { const int t = F.vcu * 6 + F.wave; if (t < 1536) p0_ada_task(a.c, a.w_ada, a.b_ada, a.modacc, scr, t, F.lane); }
    const int gw = F.vcu * NWAVES + F.wave, NGW = F.G * NWAVES;
    constexpr int I_IN = (D / 64) * (PW / 32), I_OUT = (D / 64) * (D / 32), I_G = (D / 64) * (DFF / 32), I_D = (DFF / 64) * (D / 32);
    constexpr int NITEMS = I_IN + I_OUT + 2 * I_G + I_D;
    for (int it = gw; it < NITEMS; it += NGW) {
        int r = it;
        if (r < I_IN) { p0_transpose_item<0, 1>(a.w_in, D, PW, a.Win_t, scr, r, F.lane); continue; } r -= I_IN;
        if (r < I_OUT) { p0_transpose_item<0, 0>(a.w_out, D, D, a.Wout_t, scr, r, F.lane); continue; } r -= I_OUT;
        if (r < I_G) { p0_transpose_item<1, 0>(a.w_gate, D, DFF, a.Wgu_t, scr, r, F.lane); continue; } r -= I_G;
        if (r < I_G) { p0_transpose_item<2, 0>(a.w_up, D, DFF, a.Wgu_t, scr, r, F.lane); continue; } r -= I_G;
        p0_transpose_item<0, 0>(a.w_down, DFF, D, a.Wd_t, scr, r, F.lane);
    }
}
__device__ __forceinline__ void p0b_phase(Frame& F, const float* x, const float* mod, const float* g1n, bf16_t* H, const bf16_t* Wgu_t, float* bgu) {
    const int gw = F.vcu * NWAVES + F.wave, NGW = F.G * NWAVES;
    for (int m = gw; m < M; m += NGW) {
        const int b = m / SEQ; const float* mb = mod + (size_t)b * 6 * D;
        const GAS f32x4* xr = (const GAS f32x4*)(x + (size_t)m * D) + F.lane;
        f32x4 v[8]; float s = 0.f;
#pragma unroll
        for (int j = 0; j < 8; ++j) { v[j] = xr[64 * j]; s += (v[j].x * v[j].x + v[j].y * v[j].y) + (v[j].z * v[j].z + v[j].w * v[j].w); }
        const float rstd = rsqrtf(wave_sum(s) * (1.f / D) + EPS);
        GAS unsigned long long* o8 = (GAS unsigned long long*)(H + (size_t)m * D) + F.lane;
#pragma unroll
        for (int j = 0; j < 8; ++j) { const int col = 4 * F.lane + 256 * j;
            const f32x4 sh = *(const f32x4*)(mb + col), sc = *(const f32x4*)(mb + D + col), gn = *(const f32x4*)(g1n + col);
            const f32x4 h = v[j] * rstd * gn * (sc + 1.0f) + sh;
            o8[64 * j] = (unsigned long long)pk2(h.x, h.y) | ((unsigned long long)pk2(h.z, h.w) << 32); }
    }
    LAS float* sh2s = (LAS float*)(F.lds + RING_OFF);
    for (int i = F.tid; i < 4 * D; i += NWAVES * 64) { const int b = i / D, k = i % D; sh2s[i] = mod[(size_t)b * 6 * D + 3 * D + k]; }
    __syncthreads();
    for (int nn = gw; nn < 2 * DFF; nn += NGW) {
        const int cc = nn < DFF ? nn : nn - DFF; const int row = (cc >> 7) * 256 + (nn < DFF ? 0 : 128) + (cc & 127);
        const GAS v4u* wr = (const GAS v4u*)(Wgu_t + (size_t)row * D) + F.lane;
        float a[4] = {0.f, 0.f, 0.f, 0.f};
#pragma unroll
        for (int j = 0; j < 4; ++j) { const v4u w = wr[64 * j]; const int k = 8 * (F.lane + 64 * j);
            float wf[8]; wf[0] = __uint_as_float(w.x << 16); wf[1] = __uint_as_float(w.x & 0xffff0000u); wf[2] = __uint_as_float(w.y << 16); wf[3] = __uint_as_float(w.y & 0xffff0000u);
            wf[4] = __uint_as_float(w.z << 16); wf[5] = __uint_as_float(w.z & 0xffff0000u); wf[6] = __uint_as_float(w.w << 16); wf[7] = __uint_as_float(w.w & 0xffff0000u);
#pragma unroll
            for (int b = 0; b < 4; ++b) { const f32x4 s0 = *(const LAS f32x4*)(sh2s + b * D + k), s1 = *(const LAS f32x4*)(sh2s + b * D + k + 4);
                a[b] += (wf[0] * s0.x + wf[1] * s0.y) + (wf[2] * s0.z + wf[3] * s0.w) + (wf[4] * s1.x + wf[5] * s1.y) + (wf[6] * s1.z + wf[7] * s1.w); } }
#pragma unroll
        for (int b = 0; b < 4; ++b) { const float t = wave_sum(a[b]); if (F.lane == 0) bgu[(size_t)b * 2 * DFF + nn] = t; }
    }
    __syncthreads();
}
__device__ __forceinline__ void p6_phase(Frame& F, float* out, const float* ss2, const float* fg) {
    const int gw = F.vcu * NWAVES + F.wave, NGW = F.G * NWAVES;
    for (int m = gw; m < M; m += NGW) {
        const float rstd = rsqrtf(ss2[m] * (1.f / D) + EPS);
        GAS f32x4* xr = (GAS f32x4*)(out + (size_t)m * D) + F.lane;
#pragma unroll
        for (int j = 0; j < 8; ++j) { const f32x4 gn = *(const f32x4*)(fg + 4 * F.lane + 256 * j); xr[64 * j] = xr[64 * j] * rstd * gn; }
    }
}


namespace att {
using bf16x8 = __attribute__((ext_vector_type(8))) short;
using s16x4  = __attribute__((ext_vector_type(4))) short;
using f32x16 = __attribute__((ext_vector_type(16))) float;
using u32x4  = __attribute__((ext_vector_type(4))) unsigned;
using f32x4  = __attribute__((ext_vector_type(4))) float;
#define ALAS __attribute__((address_space(3)))
#define SBAR() __builtin_amdgcn_sched_barrier(0)
constexpr int QBLK = 32, KVBLK = 64, NW = 8;
#ifndef ATT_SDEPTH
#define ATT_SDEPTH 1
#endif
constexpr float THR = 4.f;
constexpr int SHM_V = KVBLK * 128 * 2;
constexpr int L_V = 0, L_K = 2 * SHM_V, L_WS = L_K + 2 * 16384, L_LUT = L_WS + NW * 64 * 4, L_MISC = L_LUT + 4096, L_END = L_MISC + 256;
__device__ __forceinline__ int crow(int r, int hi) { return (r & 3) + 8 * (r >> 2) + 4 * hi; }
__device__ __forceinline__ unsigned cvtpk(float lo, float hi) { unsigned r; asm volatile("v_cvt_pk_bf16_f32 %0, %1, %2" : "=v"(r) : "v"(lo), "v"(hi)); return r; }
template <int DQK> __device__ __forceinline__ int kswz(int row, int colB) {
    if (DQK == 128) return row * 256 + (colB ^ ((row & 7) << 4));
    return row * 128 + (colB ^ (((row >> 1) & 7) << 4));
}
__device__ __forceinline__ int v_st(int k, int c) { const int kk = (k & ~0xC) | ((k & 4) << 1) | ((k & 8) >> 1); return ((kk >> 3) * 4 + (c >> 5)) * 512 + ((kk & 7) * 32 + (c & 31)) * 2; }
__device__ __forceinline__ int v_rd_base(int lane) { return ((lane & 3) << 3) | (((lane >> 2) & 3) << 6) | (((lane >> 4) & 1) << 5) | (((lane >> 5) & 1) << 8); }
constexpr int v_rd_off(int d0, int ks, int half) { return d0 * 512 + ks * 4096 + half * 2048; }
template <int OFF> __device__ __forceinline__ s16x4 tr_read(int vb) {
    s16x4 r; asm volatile("ds_read_b64_tr_b16 %0, %1 offset:%2" : "=&v"(r) : "v"(vb), "i"(OFF) : "memory"); return r;
}
template <int D0> __device__ __forceinline__ void pv_one(f32x16& od, int vb, bf16x8 pa0, bf16x8 pa1, bf16x8 pa2, bf16x8 pa3) {
    const s16x4 l0 = tr_read<v_rd_off(D0, 0, 0)>(vb), h0 = tr_read<v_rd_off(D0, 0, 1)>(vb), l1 = tr_read<v_rd_off(D0, 1, 0)>(vb), h1 = tr_read<v_rd_off(D0, 1, 1)>(vb);
    const s16x4 l2 = tr_read<v_rd_off(D0, 2, 0)>(vb), h2 = tr_read<v_rd_off(D0, 2, 1)>(vb), l3 = tr_read<v_rd_off(D0, 3, 0)>(vb), h3 = tr_read<v_rd_off(D0, 3, 1)>(vb);
    asm volatile("s_waitcnt lgkmcnt(0)" ::: "memory"); SBAR();
#define PK(L, H) (bf16x8){L[0], L[1], L[2], L[3], H[0], H[1], H[2], H[3]}
    od = __builtin_amdgcn_mfma_f32_32x32x16_bf16(pa0, PK(l0, h0), od, 0, 0, 0);
    od = __builtin_amdgcn_mfma_f32_32x32x16_bf16(pa1, PK(l1, h1), od, 0, 0, 0);
    od = __builtin_amdgcn_mfma_f32_32x32x16_bf16(pa2, PK(l2, h2), od, 0, 0, 0);
    od = __builtin_amdgcn_mfma_f32_32x32x16_bf16(pa3, PK(l3, h3), od, 0, 0, 0);
#undef PK
}
__device__ __forceinline__ void pv_d0(f32x16* o, int vb, bf16x8 pa0, bf16x8 pa1, bf16x8 pa2, bf16x8 pa3) {
    pv_one<0>(o[0], vb, pa0, pa1, pa2, pa3); pv_one<1>(o[1], vb, pa0, pa1, pa2, pa3); pv_one<2>(o[2], vb, pa0, pa1, pa2, pa3); pv_one<3>(o[3], vb, pa0, pa1, pa2, pa3);
}
__device__ __forceinline__ void partialSM(f32x16& p0, f32x16& p1, float& m_reg, float& alpha) {
    float pmax = p0[0];
#pragma unroll
    for (int r = 1; r < 16; ++r) pmax = fmaxf(pmax, p0[r]);
#pragma unroll
    for (int r = 0; r < 16; ++r) pmax = fmaxf(pmax, p1[r]);
    { auto rr = __builtin_amdgcn_permlane32_swap(__float_as_uint(pmax), __float_as_uint(pmax), false, false);
      pmax = fmaxf(__uint_as_float(rr[0]), __uint_as_float(rr[1])); }
    float mn;
    if (__builtin_expect(__all(pmax - m_reg <= THR), 1)) { mn = m_reg; alpha = 1.f; }
    else { mn = fmaxf(m_reg, pmax); alpha = __builtin_amdgcn_exp2f(m_reg - mn); m_reg = mn; }
#pragma unroll
    for (int r = 0; r < 16; ++r) p0[r] = __builtin_amdgcn_exp2f(p0[r] - mn);
#pragma unroll
    for (int r = 0; r < 16; ++r) p1[r] -= mn;
}
__device__ __forceinline__ void finishSM(f32x16& p0, f32x16& p1, float alpha, float& l_reg, bf16x8& pa0, bf16x8& pa1, bf16x8& pa2, bf16x8& pa3) {
#pragma unroll
    for (int r = 0; r < 16; ++r) p1[r] = __builtin_amdgcn_exp2f(p1[r]);
    float ps = 0;
#pragma unroll
    for (int r = 0; r < 16; ++r) ps += p0[r];
#pragma unroll
    for (int r = 0; r < 16; ++r) ps += p1[r];
    { auto rr = __builtin_amdgcn_permlane32_swap(__float_as_uint(ps), __float_as_uint(ps), false, false);
      ps = __uint_as_float(rr[0]) + __uint_as_float(rr[1]); }
    l_reg = l_reg * alpha + ps;
#define PK4(P, BASE, OUT) do { unsigned a0 = cvtpk(P[BASE + 0], P[BASE + 1]), a1 = cvtpk(P[BASE + 2], P[BASE + 3]);   \
    unsigned b0 = cvtpk(P[BASE + 4], P[BASE + 5]), b1 = cvtpk(P[BASE + 6], P[BASE + 7]);                              \
    auto r0 = __builtin_amdgcn_permlane32_swap(a0, b0, false, false); auto r1 = __builtin_amdgcn_permlane32_swap(a1, b1, false, false); \
    u32x4 w = {r0[0], r1[0], r0[1], r1[1]}; OUT = *reinterpret_cast<bf16x8*>(&w); } while (0)
    PK4(p0, 0, pa0); PK4(p0, 8, pa1); PK4(p1, 0, pa2); PK4(p1, 8, pa3);
#undef PK4
}
template <int DQK> __device__ __forceinline__ void qkt(f32x16& p0, f32x16& p1, const ALAS char* Ks, const bf16x8* qr, int r32, int hi) {
#pragma unroll
    for (int d0 = 0; d0 < DQK / 16; ++d0) { const int cb = (d0 * 16 + hi * 8) * 2;
        const bf16x8 b0 = *reinterpret_cast<const ALAS bf16x8*>(Ks + kswz<DQK>(r32, cb));
        const bf16x8 b1 = *reinterpret_cast<const ALAS bf16x8*>(Ks + kswz<DQK>(32 + r32, cb));
        p0 = __builtin_amdgcn_mfma_f32_32x32x16_bf16(b0, qr[d0], p0, 0, 0, 0);
        p1 = __builtin_amdgcn_mfma_f32_32x32x16_bf16(b1, qr[d0], p1, 0, 0, 0); }
}

struct DaBias {
    const ALAS float* lut; float cneg, cpos; int q0w, lbase;
    __device__ __forceinline__ void init(int j, f32x16& p0, f32x16& p1) const {
        const int k0 = j * KVBLK, rel_min = k0 - q0w - 31, rel_max = k0 + 63 - q0w;
        if (rel_min >= 91) {
#pragma unroll
            for (int r = 0; r < 16; ++r) { p0[r] = cpos; p1[r] = cpos; }
        } else if (rel_max <= -91) {
#pragma unroll
            for (int r = 0; r < 16; ++r) { p0[r] = cneg; p1[r] = cneg; }
        } else {
            const ALAS float* lp = lut + (k0 + lbase);
#pragma unroll
            for (int r = 0; r < 16; ++r) { p0[r] = lp[crow(r, 0)]; p1[r] = lp[32 + crow(r, 0)]; }
        }
    }
};
struct NaBias {
    const ALAS float* tab; int bs, rw, rsw, lbase; unsigned mask0, mask1;
    __device__ __forceinline__ void init(int j, f32x16& p0, f32x16& p1) const {
        const int kr = bs + j; const float NEG = -INFINITY;
        if (kr < rsw || kr >= rsw + 8) {
#pragma unroll
            for (int r = 0; r < 16; ++r) { p0[r] = NEG; p1[r] = NEG; }
        } else {
            const ALAS float* lp = tab + ((kr - rw + 7) * 32 + lbase);
#pragma unroll
            for (int r = 0; r < 16; ++r) { const float a = lp[crow(r, 0)], b = lp[32 + crow(r, 0)];
                p0[r] = ((mask0 >> r) & 1u) ? a : NEG; p1[r] = ((mask1 >> r) & 1u) ? b : NEG; }
        }
    }
};

template <int DQK, class Bias, int SDEPTH>
__device__ __forceinline__ void attn_pass(const bf16_t* __restrict__ Qb, const bf16_t* __restrict__ Kh, const bf16_t* __restrict__ Vh, int NT, const Bias& B,
                                          ALAS char* lds, f32x16 (&o)[4], float& l_reg) {
    const int tid = threadIdx.x, wid = __builtin_amdgcn_readfirstlane(tid >> 6), lane = tid & 63, r32 = lane & 31, hi = lane >> 5;
    ALAS char* V_lds = lds + L_V; ALAS char* K_lds = lds + L_K; constexpr int SHM_K = KVBLK * DQK * 2;
    ALAS float* ws = (ALAS float*)(lds + L_WS) + wid * 64; ALAS float* al_l = ws + 32;
    float m_reg = -1e30f; l_reg = 0.f;
#pragma unroll
    for (int d = 0; d < 4; ++d)
#pragma unroll
        for (int r = 0; r < 16; ++r) o[d][r] = 0.f;
    bf16x8 qr[DQK / 16];
    { const char* Qt = (const char*)(Qb + (size_t)(wid * QBLK) * PW); const unsigned qo = (unsigned)((r32 * PW + hi * 8) * 2);
#pragma unroll
    for (int d0 = 0; d0 < DQK / 16; ++d0) qr[d0] = *reinterpret_cast<const bf16x8*>(Qt + qo + d0 * 32); }
    const int sr = tid >> 4, sc = (tid & 15) * 8, vst0 = v_st(sr, sc), vst1 = v_st(32 + sr, sc);
    const int ksr = DQK == 128 ? sr : (tid >> 3), ksc = DQK == 128 ? sc : (tid & 7) * 8;
    const int vb0 = (int)(uintptr_t)V_lds + v_rd_base(lane);
    const char* Vt = (const char*)Vh; const char* Kt = (const char*)Kh;
    const unsigned voV0 = (unsigned)((sr * PW + sc) * 2), voV1 = voV0 + 32u * PW * 2u, voK0 = (unsigned)((ksr * PW + ksc) * 2), voK1 = voK0 + 32u * PW * 2u;
    struct { bf16x8 vs0, vs1, ks0, ks1; } sr_[SDEPTH];
#define SLOAD(i, k0) do { const char* vt_ = Vt + (size_t)(k0) * (PW * 2); const char* kt_ = Kt + (size_t)(k0) * (PW * 2); \
    sr_[i].vs0 = *reinterpret_cast<const bf16x8*>(vt_ + voV0); sr_[i].vs1 = *reinterpret_cast<const bf16x8*>(vt_ + voV1); \
    sr_[i].ks0 = *reinterpret_cast<const bf16x8*>(kt_ + voK0); if (DQK == 128) sr_[i].ks1 = *reinterpret_cast<const bf16x8*>(kt_ + voK1); } while (0)
#define SWRITE(b, i) do { *(ALAS bf16x8*)(V_lds + (b) * SHM_V + vst0) = sr_[i].vs0; *(ALAS bf16x8*)(V_lds + (b) * SHM_V + vst1) = sr_[i].vs1; \
    *(ALAS bf16x8*)(K_lds + (b) * SHM_K + kswz<DQK>(ksr, ksc * 2)) = sr_[i].ks0; if (DQK == 128) *(ALAS bf16x8*)(K_lds + (b) * SHM_K + kswz<DQK>(32 + ksr, ksc * 2)) = sr_[i].ks1; } while (0)
#define SWAIT() do { if (SDEPTH == 1) asm volatile("s_waitcnt vmcnt(0)" ::: "memory"); else if (DQK == 128) asm volatile("s_waitcnt vmcnt(4)" ::: "memory"); else asm volatile("s_waitcnt vmcnt(3)" ::: "memory"); } while (0)
#define RESC(a) do { if (__any((a) < 1.f)) { if (hi == 0) al_l[r32] = (a); asm volatile("s_waitcnt lgkmcnt(0)" ::: "memory"); \
    _Pragma("unroll") for (int d = 0; d < 4; ++d) _Pragma("unroll") for (int r = 0; r < 16; ++r) o[d][r] *= al_l[crow(r, hi)]; } } while (0)
    f32x16 pA0, pA1, pB0, pB1; float alA, alB; bf16x8 pa0, pa1, pa2, pa3;
    constexpr int SE = 0, SO = SDEPTH - 1;
    SLOAD(SE, 0); asm volatile("s_waitcnt vmcnt(0)" ::: "memory"); SWRITE(0, SE); __syncthreads();
    B.init(0, pA0, pA1); qkt<DQK>(pA0, pA1, K_lds, qr, r32, hi); partialSM(pA0, pA1, m_reg, alA);
    SLOAD(SO, KVBLK); if (SDEPTH == 2) { if (2 < NT) SLOAD(SE, 2 * KVBLK); }
    SWAIT(); SWRITE(1, SO); __syncthreads();
    for (int j = 1; j + 1 < NT; j += 2) {
        SBAR(); B.init(j, pB0, pB1); qkt<DQK>(pB0, pB1, K_lds + SHM_K, qr, r32, hi);
        finishSM(pA0, pA1, alA, l_reg, pa0, pa1, pa2, pa3); SBAR();
        SLOAD(SO, (j + SDEPTH) * KVBLK); SBAR();
        pv_d0(o, vb0, pa0, pa1, pa2, pa3); partialSM(pB0, pB1, m_reg, alB);
        __syncthreads(); SWAIT(); SWRITE(0, SE);
        RESC(alB); __syncthreads();
        SBAR(); B.init(j + 1, pA0, pA1); qkt<DQK>(pA0, pA1, K_lds, qr, r32, hi);
        finishSM(pB0, pB1, alB, l_reg, pa0, pa1, pa2, pa3); SBAR();
        if (SDEPTH == 1 || j + 3 < NT) SLOAD(SE, (j + 1 + SDEPTH) * KVBLK); SBAR();
        pv_d0(o, vb0 + SHM_V, pa0, pa1, pa2, pa3); partialSM(pA0, pA1, m_reg, alA);
        __syncthreads(); SWAIT(); SWRITE(1, SO);
        RESC(alA); __syncthreads();
    }
    SBAR(); B.init(NT - 1, pB0, pB1); qkt<DQK>(pB0, pB1, K_lds + SHM_K, qr, r32, hi);
    finishSM(pA0, pA1, alA, l_reg, pa0, pa1, pa2, pa3); SBAR();
    pv_d0(o, vb0, pa0, pa1, pa2, pa3); partialSM(pB0, pB1, m_reg, alB);
    __syncthreads(); RESC(alB);
    finishSM(pB0, pB1, alB, l_reg, pa0, pa1, pa2, pa3); SBAR();
    pv_d0(o, vb0 + SHM_V, pa0, pa1, pa2, pa3);
    asm volatile("s_waitcnt vmcnt(0)" ::: "memory");
    __syncthreads();
#undef SLOAD
#undef SWRITE
#undef SWAIT
#undef RESC
}
__device__ __forceinline__ void normalize_o(f32x16 (&o)[4], float l_reg, ALAS float* ws, int r32, int hi) {
    if (hi == 0) ws[r32] = l_reg; asm volatile("s_waitcnt lgkmcnt(0)" ::: "memory");
#pragma unroll
    for (int r = 0; r < 16; ++r) { const float rl = __builtin_amdgcn_rcpf(ws[crow(r, hi)]);
#pragma unroll
        for (int d = 0; d < 4; ++d) o[d][r] *= rl; }
    asm volatile("s_waitcnt lgkmcnt(0)" ::: "memory");
}
__device__ __forceinline__ void row_sumsq(const f32x16 (&o)[4], ALAS float* scr, ALAS float* rowss, int lane, int r32, int hi) {
#pragma unroll
    for (int r = 0; r < 16; ++r) { float s = 0.f;
#pragma unroll
        for (int d = 0; d < 4; ++d) s += o[d][r] * o[d][r];
        scr[crow(r, hi) * 33 + r32] = s; }
    asm volatile("s_waitcnt lgkmcnt(0)" ::: "memory");
    float t = 0.f;
#pragma unroll
    for (int i = 0; i < 16; ++i) t += scr[r32 * 33 + hi * 16 + i];
    t += __shfl_xor(t, 32);
    if (hi == 0) rowss[r32] = t;
    asm volatile("s_waitcnt lgkmcnt(0)" ::: "memory");
}
__device__ __forceinline__ void store_rows_bf16(const f32x16 (&y)[4], ALAS bf16_t* stg, bf16_t* dst, int lane, int r32, int hi) {
#pragma unroll
    for (int r = 0; r < 16; ++r) { const int orow = crow(r, hi);
#pragma unroll
        for (int d0 = 0; d0 < 4; ++d0) stg[orow * 128 + d0 * 32 + r32] = f2bf(y[d0][r]); }
    asm volatile("s_waitcnt lgkmcnt(0)" ::: "memory");
#pragma unroll 1
    for (int i = 0; i < 8; ++i) { const int row = i * 4 + (lane >> 4), ch = lane & 15; const u32x4 v = *(const ALAS u32x4*)(stg + row * 128 + ch * 8); *(u32x4*)(dst + (size_t)row * D + ch * 8) = v; }
    asm volatile("s_waitcnt lgkmcnt(0)" ::: "memory");
}

struct AttnArgs { const bf16_t* PROJ; bf16_t* AO; float* ssna; float* scratch; const float* rpb; const float* gout; const float* lamp; const float* subg; const float* t5; };

__device__ __forceinline__ void da_unit(const AttnArgs& A, int u, ALAS char* lds) {
    const int tid = threadIdx.x, wid = __builtin_amdgcn_readfirstlane(tid >> 6), lane = tid & 63, r32 = lane & 31, hi = lane >> 5;
    const int b = u >> 6, h = (u >> 3) & 7, qb = u & 7;
    ALAS float* lut = (ALAS float*)(lds + L_LUT); ALAS float* misc = (ALAS float*)(lds + L_MISC);
    { const int rel = tid - 256; lut[tid] = A.t5[t5_bucket(rel) * NH + h] * LOG2E; }
    if (wid == 0) { float a = A.lamp[lane] * A.lamp[64 + lane], c = A.lamp[128 + lane] * A.lamp[192 + lane];
#pragma unroll
        for (int off = 1; off < 64; off <<= 1) { a += __shfl_xor(a, off); c += __shfl_xor(c, off); }
        if (lane == 0) misc[0] = __expf(a) - __expf(c) + LAM_INIT; }
    __syncthreads();
    const float lam = misc[0];
    const size_t tok0 = (size_t)b * SEQ + qb * 256, ktok0 = (size_t)b * SEQ;
    DaBias B; B.lut = lut; B.cneg = A.t5[15 * NH + h] * LOG2E; B.cpos = A.t5[31 * NH + h] * LOG2E; B.q0w = qb * 256 + wid * 32; B.lbase = 256 - B.q0w - r32 + 4 * hi;
    ALAS float* ws = (ALAS float*)(lds + L_WS) + wid * 64;
    f32x16 o[4]; float l_reg; int nt = SEQ / KVBLK; asm volatile("" : "+s"(nt));
    float* scr_g = A.scratch + ((size_t)u * NW + wid) * (64 * 64);
    attn_pass<64, DaBias, ATT_SDEPTH>(A.PROJ + tok0 * PW + O_DAQ + h * HD, A.PROJ + ktok0 * PW + O_DAK + h * HD, A.PROJ + ktok0 * PW + O_DAV + h * HD, nt, B, lds, o, l_reg);
    int lane1 = lane; asm volatile("" : "+v"(lane1)); const int r32a = lane1 & 31, hia = lane1 >> 5;
    normalize_o(o, l_reg, ws, r32a, hia);
    { char* sp = (char*)scr_g; const unsigned so = (unsigned)lane1 * 16u;
#pragma unroll
      for (int i = 0; i < 16; ++i) { const int d = i >> 2, g = i & 3; *(f32x4*)(sp + so + i * 1024) = (f32x4){o[d][4 * g], o[d][4 * g + 1], o[d][4 * g + 2], o[d][4 * g + 3]}; } }
    attn_pass<64, DaBias, ATT_SDEPTH>(A.PROJ + tok0 * PW + O_DAQ + h * HD + 64, A.PROJ + ktok0 * PW + O_DAK + h * HD + 64, A.PROJ + ktok0 * PW + O_DAV + h * HD, nt, B, lds, o, l_reg);
    int lane2 = lane; asm volatile("" : "+v"(lane2)); const int r32b = lane2 & 31, hib = lane2 >> 5;
    normalize_o(o, l_reg, ws, r32b, hib);
    asm volatile("s_waitcnt vmcnt(0)" ::: "memory");
    { unsigned long long spv = (unsigned long long)(uintptr_t)(A.scratch + ((size_t)u * NW + wid) * (64 * 64)); asm volatile("" : "+s"(spv));
      const char* sp = (const char*)(uintptr_t)spv; const unsigned so = (unsigned)lane2 * 16u;
#pragma unroll
      for (int i = 0; i < 16; ++i) { const int d = i >> 2, g = i & 3; const f32x4 v = *(const f32x4*)(sp + so + i * 1024);
          o[d][4 * g] = v[0] - lam * o[d][4 * g]; o[d][4 * g + 1] = v[1] - lam * o[d][4 * g + 1]; o[d][4 * g + 2] = v[2] - lam * o[d][4 * g + 2]; o[d][4 * g + 3] = v[3] - lam * o[d][4 * g + 3]; } }
    ALAS float* scr = (ALAS float*)(lds + L_V + wid * 8192);
    row_sumsq(o, scr, ws, lane2, r32b, hib);
    float gs[4];
#pragma unroll
    for (int d = 0; d < 4; ++d) gs[d] = A.subg[d * 32 + r32b] * (1.f - LAM_INIT);
#pragma unroll
    for (int r = 0; r < 16; ++r) { const float rstd = rsqrtf(ws[crow(r, hib)] * (1.f / HD) + EPS);
#pragma unroll
        for (int d = 0; d < 4; ++d) o[d][r] = o[d][r] * rstd * gs[d]; }
    asm volatile("s_waitcnt lgkmcnt(0)" ::: "memory");
    ALAS bf16_t* stg = (ALAS bf16_t*)(lds + L_V) + wid * (32 * 128);
    store_rows_bf16(o, stg, A.AO + (tok0 + wid * 32) * D + 1024 + h * HD, lane2, r32b, hib);
    __syncthreads();
}
__device__ __forceinline__ void na_unit(const AttnArgs& A, int u, ALAS char* lds) {
    const int tid = threadIdx.x, wid = __builtin_amdgcn_readfirstlane(tid >> 6), lane = tid & 63, r32 = lane & 31, hi = lane >> 5;
    const int b = u >> 6, h = (u >> 3) & 7, rblk = u & 7, r0 = rblk * 4;
    ALAS float* tab = (ALAS float*)(lds + L_LUT);
    for (int i = tid; i < 1024; i += NW * 64) tab[i] = 0.f;
    __syncthreads();
    if (tid < 15 * 32) { const int rr = tid >> 5, cc = tid & 31; if (cc < 31) tab[64 + rr * 32 + cc] = A.rpb[(h * 15 + rr) * 31 + cc] * LOG2E; }
    __syncthreads();
    const int bs = min(max(r0 - 4, 0), 24), be = min(max(r0 + 3 - 4, 0), 24) + 7; int NT = be - bs + 1; NT += NT & 1;
    const int rw = r0 + (wid >> 1), qc = 32 * (wid & 1) + r32, cs = min(max(qc - 8, 0), 48);
    NaBias B; B.tab = tab; B.bs = bs; B.rw = rw; B.rsw = min(max(rw - 4, 0), 24); B.lbase = 64 + 4 * hi - qc + 15;
    unsigned m0 = 0u, m1 = 0u;
#pragma unroll
    for (int r = 0; r < 16; ++r) { const int kc = crow(r, hi); if (kc >= cs && kc < cs + 16) m0 |= 1u << r; if (kc + 32 >= cs && kc + 32 < cs + 16) m1 |= 1u << r; }
    B.mask0 = m0; B.mask1 = m1;
    const size_t tok0 = (size_t)b * SEQ + r0 * 64, ktok0 = (size_t)b * SEQ + bs * 64;
    ALAS float* ws = (ALAS float*)(lds + L_WS) + wid * 64;
    f32x16 o[4]; float l_reg;
    attn_pass<128, NaBias, ATT_SDEPTH>(A.PROJ + tok0 * PW + O_NAQ + h * HD, A.PROJ + ktok0 * PW + O_NAK + h * HD, A.PROJ + ktok0 * PW + O_NAV + h * HD, NT, B, lds, o, l_reg);
    int lane2 = lane; asm volatile("" : "+v"(lane2)); const int r32b = lane2 & 31, hib = lane2 >> 5;
    normalize_o(o, l_reg, ws, r32b, hib);
    ALAS float* scr = (ALAS float*)(lds + L_V + wid * 8192);
    row_sumsq(o, scr, ws, lane2, r32b, hib);
    if (hib == 0) atomicAdd(A.ssna + tok0 + wid * 32 + r32b, ws[r32b]);
    float gs[4];
#pragma unroll
    for (int d = 0; d < 4; ++d) gs[d] = A.gout[h * HD + d * 32 + r32b];
#pragma unroll
    for (int r = 0; r < 16; ++r)
#pragma unroll
        for (int d = 0; d < 4; ++d) o[d][r] *= gs[d];
    ALAS bf16_t* stg = (ALAS bf16_t*)(lds + L_V) + wid * (32 * 128);
    store_rows_bf16(o, stg, A.AO + (tok0 + wid * 32) * D + h * HD, lane2, r32b, hib);
    __syncthreads();
}
#undef SBAR
}

struct Args { const float* in[17]; float* out; unsigned char* ws; int ph_lo, ph_hi, li, pad; };
enum { PH_0A = 0, PH_0B = 1, PH_1 = 2, PH_2 = 3, PH_3 = 4, PH_4 = 5, PH_5 = 6, PH_6 = 7, PH_N = 8 };
__global__ void __launch_bounds__(NWAVES * 64, 2) mega(Args args) {
    extern __shared__ __attribute__((aligned(16))) unsigned char lds[];
    Frame F;
    F.lds = (LAS unsigned char*)lds;
    F.MISC = (volatile LAS unsigned*)(F.lds + MISC_OFF);
    F.tid = threadIdx.x; F.lane = F.tid & 63; F.wave = __builtin_amdgcn_readfirstlane(F.tid >> 6);
    F.G = gridDim.x; { const int bx = blockIdx.x; F.vcu = (F.G % 8 == 0) ? (bx % 8) * (F.G / 8) + bx / 8 : bx; }
    unsigned char* ws = args.ws;
    F.ctl = (gu32*)(ws + WS_CTL);
    const float* x = args.in[0]; const float* c = args.in[1]; const float* w_ada = args.in[2]; const float* b_ada = args.in[3];
    const float* norm1_g = args.in[4]; const float* w_in = args.in[5]; const float* w_out = args.in[11];
    const float* norm2_g = args.in[12]; const float* w_gate = args.in[13]; const float* w_up = args.in[14]; const float* w_down = args.in[15]; const float* final_g = args.in[16];
    float* mod = (float*)(ws + CTL_MOD); float* ssna = (float*)(ws + CTL_SSNA); float* ss1 = (float*)(ws + CTL_SS1); float* ss2 = (float*)(ws + CTL_SS2);
    float* bgu = (float*)(ws + WS_BGU);
    bf16_t* Win_t = (bf16_t*)(ws + WS_WIN); bf16_t* Wout_t = (bf16_t*)(ws + WS_WOUT); bf16_t* Wgu_t = (bf16_t*)(ws + WS_WGU); bf16_t* Wd_t = (bf16_t*)(ws + WS_WD);
    bf16_t* H = (bf16_t*)(ws + WS_H); bf16_t* AO = H; bf16_t* PROJ = (bf16_t*)(ws + WS_PROJ); bf16_t* ACT = PROJ;
    float* X1 = (float*)(ws + WS_X1); bf16_t* A2 = (bf16_t*)(ws + WS_A2);
    for (int u = F.tid; u < (LDS_BYTES - LDSCTL_OFF) / 4; u += NWAVES * 64) ((LAS unsigned*)(F.lds + LDSCTL_OFF))[u] = 0u;
    __syncthreads();
    XcdBarrier bar = xcd_barrier_post((unsigned*)(F.ctl + CW_BAR) + args.li * XCD_BAR_WORDS, F.MISC + 8);
    const int lo = args.ph_lo, hi = args.ph_hi;
#define IN(k) (lo <= (k) && (k) < hi)
#define SEAM(k) do { if (IN(k) && IN((k) + 1)) xcd_barrier(bar); } while (0)

    if (IN(PH_0A)) { P0Args a{c, w_ada, b_ada, w_in, w_out, w_gate, w_up, w_down, mod, Win_t, Wout_t, Wgu_t, Wd_t}; p0a_phase(F, a); __syncthreads(); }
    SEAM(PH_0A);
    if (IN(PH_0B)) { p0b_phase(F, x, mod, norm1_g, H, Wgu_t, bgu); }
    SEAM(PH_0B);
    if (IN(PH_1)) {
        pg8::Gemm g{H, Win_t, M, PW, D}; pg8::StaticOrder S; S.init(M, PW, F.G, (int)blockIdx.x);
        pg8::EpiProj E{PROJ};
        pg8::gemm_phase<pg8::EpiProj, pg8::StaticOrder, true, true>(F.lds + RING_OFF, g, S, E);
    }
    SEAM(PH_1);
    if (IN(PH_2)) {
        att::AttnArgs A{PROJ, AO, ssna, (float*)(ws + WS_A2), args.in[6], args.in[7], args.in[8], args.in[9], args.in[10]};
        for (int u = F.vcu; u < 256; u += F.G) att::da_unit(A, u, (LAS char*)F.lds);
        for (int u = F.vcu; u < 256; u += F.G) att::na_unit(A, u, (LAS char*)F.lds);
    }
    SEAM(PH_2);
    if (IN(PH_3)) {
        pg8::Gemm g{AO, Wout_t, M, D, D}; pg8::StaticOrder S; S.init(M, D, F.G, (int)blockIdx.x);
        pg8::EpiMix E{x, mod, norm2_g, ssna, X1, A2, ss1};
        pg8::gemm_phase<pg8::EpiMix, pg8::StaticOrder, true, true>(F.lds + RING_OFF, g, S, E);
    }
    SEAM(PH_3);
    if (IN(PH_4)) {
        pg8::Gemm g{A2, Wgu_t, M, 2 * DFF, D}; pg8::StaticOrder S; S.init(M, 2 * DFF, F.G, (int)blockIdx.x);
        pg8::EpiGU E{ss1, bgu, ACT};
        pg8::gemm_phase<pg8::EpiGU, pg8::StaticOrder, true, true>(F.lds + RING_OFF, g, S, E);
    }
    SEAM(PH_4);
    if (IN(PH_5)) {
        pg8::Gemm g{ACT, Wd_t, M, D, DFF}; pg8::StaticOrder S; S.init(M, D, F.G, (int)blockIdx.x);
        pg8::EpiDown E{X1, mod, args.out, ss2};
        pg8::gemm_phase<pg8::EpiDown, pg8::StaticOrder, true, true>(F.lds + RING_OFF, g, S, E);
    }
    SEAM(PH_5);
    if (IN(PH_6)) { p6_phase(F, args.out, ss2, final_g); }
#undef IN
#undef SEAM
}

extern "C" void kernel_launch(void* const* d_in, const int* in_sizes, int n_in, void* d_out, int out_size, void* d_ws, size_t ws_size, hipStream_t stream) {
    static int grid = 0;
    if (grid == 0) {
        if (n_in != 17 || out_size != M * D || ws_size < WS_END) { fprintf(stderr, "kernel_launch: unexpected shapes n_in %d out %d ws %zu\n", n_in, out_size, ws_size); grid = -1; return; }
        int dev = 0, cus = 0, per_cu = 0;
        if (hipGetDevice(&dev) != hipSuccess || hipDeviceGetAttribute(&cus, hipDeviceAttributeMultiprocessorCount, dev) != hipSuccess) { grid = -1; return; }
        if (hipFuncSetAttribute((const void*)mega, hipFuncAttributeMaxDynamicSharedMemorySize, LDS_BYTES) != hipSuccess) { fprintf(stderr, "kernel_launch: hipFuncSetAttribute failed\n"); grid = -1; return; }
        if (hipOccupancyMaxActiveBlocksPerMultiprocessor(&per_cu, (const void*)mega, NWAVES * 64, LDS_BYTES) != hipSuccess || per_cu < 1) { fprintf(stderr, "kernel_launch: occupancy query says %d\n", per_cu); per_cu = 1; }
        (void)hipGetLastError();
        grid = cus;
        if (grid != 256) fprintf(stderr, "kernel_launch: grid %d (expected 256)\n", grid);
    }
    if (grid < 0) return;
    char* ws = (char*)d_ws;
    (void)hipMemsetAsync(ws + WS_CTL, 0, CTL_BYTES, stream);
    Args a{};
    for (int i = 0; i < 17; ++i) a.in[i] = (const float*)d_in[i];
    a.out = (float*)d_out; a.ws = (unsigned char*)d_ws;
    a.ph_lo = PH_0A; a.ph_hi = PH_N; a.li = 0;
    hipLaunchKernelGGL(mega, dim3(grid), dim3(NWAVES * 64), LDS_BYTES, stream, a);
    const hipError_t le = hipPeekAtLastError();
    if (le != hipSuccess) fprintf(stderr, "kernel_launch: launch failed: %s\n", hipGetErrorName(le));
}
```

```cpp
#include <hip/hip_runtime.h>
#include <cstdio>
#include <cstdint>

typedef unsigned short bf16_t;
constexpr int BATCH = 4, SEQ = 2048, D = 2048, M = BATCH * SEQ;
constexpr int NH = 8, HD = 128, DQ = 64, PW = 6144, DFF = 5632;
constexpr int O_NAQ = 0, O_NAK = 1024, O_NAV = 2048, O_DAQ = 3072, O_DAK = 4096, O_DAV = 5120;
constexpr float EPS = 1e-6f;
constexpr float LOG2E = 1.4426950408889634f;
constexpr float C_NA = 0.08838834764831845f * LOG2E;
constexpr float C_DA = 0.125f * LOG2E;
constexpr float LAM_INIT = 0.2f;

constexpr size_t MiB = 1u << 20;
constexpr size_t WS_CTL = 0, CTL_BYTES = 1 * MiB;
constexpr int    CW_BAR = 4096;
constexpr size_t CTL_MOD = 128 * 1024;
constexpr size_t CTL_SSNA = 320 * 1024, CTL_SS1 = 352 * 1024, CTL_SS2 = 384 * 1024;
constexpr size_t CTL_DUMMY = 512 * 1024;
constexpr size_t WS_BGU = 1 * MiB;
constexpr size_t WS_WIN = 2 * MiB, WS_WOUT = 26 * MiB, WS_WGU = 34 * MiB, WS_WD = 78 * MiB;
constexpr size_t WS_H = 100 * MiB;
constexpr size_t WS_PROJ = 132 * MiB;
constexpr size_t WS_X1 = 228 * MiB;
constexpr size_t WS_A2 = 292 * MiB;
constexpr size_t WS_END = 324 * MiB;

__device__ __forceinline__ float bf2f(bf16_t v) { return __uint_as_float(((unsigned)v) << 16); }
__device__ __forceinline__ bf16_t f2bf(float f) { unsigned u = __float_as_uint(f); return (bf16_t)((u + 0x7fffu + ((u >> 16) & 1u)) >> 16); }
__device__ __forceinline__ unsigned pk2(float lo, float hi) { return (unsigned)f2bf(lo) | ((unsigned)f2bf(hi) << 16); }
__device__ __forceinline__ float silu_f(float v) { return v / (1.f + __expf(-v)); }
__device__ __forceinline__ float silu_fast(float v) { return v * __builtin_amdgcn_rcpf(1.f + __builtin_amdgcn_exp2f(-v * LOG2E)); }
__device__ __forceinline__ int t5_bucket(int rel) {
    const int n = rel < 0 ? -rel : rel; int b;
    if (n < 8) b = n; else if (n < 12) b = 8; else if (n < 16) b = 9; else if (n < 23) b = 10; else if (n < 32) b = 11;
    else if (n < 46) b = 12; else if (n < 64) b = 13; else if (n < 91) b = 14; else b = 15;
    return b + (rel > 0 ? 16 : 0);
}

namespace pg8 {
#define PG8_LAS __attribute__((address_space(3)))
typedef short bf16x8 __attribute__((ext_vector_type(8)));
typedef float f32x4 __attribute__((ext_vector_type(4)));
typedef unsigned u32x4 __attribute__((ext_vector_type(4)));
constexpr int BM = 256, BK = 64, HALF = 128, HTB = HALF * BK * 2  , STAGE_BYTES = 8 * HTB, NXCD = 8, WGM = 8;

__host__ __device__ __forceinline__ int lds_byte(int r, int c) { const int st = (r >> 4) * 2 + (c >> 5), rr = r & 15, cc = c & 31, ob = rr * 64 + cc * 2; return st * 1024 + (ob ^ (((ob >> 9) & 1) << 5)); }
__host__ __device__ __forceinline__ void stage_rc(int b, int& R, int& C) { const int st = b / 1024, sb = b % 1024, swz = sb ^ (((sb >> 9) & 1) << 5); R = (st >> 1) * 16 + swz / 64; C = (st & 1) * 32 + (swz % 64) / 2; }
__host__ __device__ __forceinline__ int perm32(int rho) { const int n = rho >> 4, i = rho & 15; return 8 * (i >> 2) + 4 * n + (i & 3); }

struct Unit { int pm, pn; };
struct Gemm { const bf16_t* A; const bf16_t* Bt; int M, N, K; };

struct StaticOrder {
    int nM, nN, nwg, G, c;
    __host__ __device__ void init(int M, int N, int G_, int c_) { nM = M / BM; nN = N / BM; nwg = nM * nN; G = G_; c = c_; }
    __host__ __device__ bool next(int i, Unit& u) const {
        const long L = (long)i * G + c; if (L >= nwg) return false;
        int wgid = (int)L; { const int q = nwg / NXCD, r = nwg % NXCD, xcd = wgid % NXCD, off = wgid / NXCD; wgid = (xcd < r ? xcd * (q + 1) : r * (q + 1) + (xcd - r) * q) + off; }
        const int nig = WGM * nN, gid = wgid / nig, fm = gid * WGM, gsz = (nM - fm) < WGM ? (nM - fm) : WGM;
        u.pm = fm + ((wgid % nig) % gsz); u.pn = (wgid % nig) / gsz; return true;
    }
    __device__ __forceinline__ void a_ready(const Unit&) const {}
    __device__ __forceinline__ void done(const Unit&) const {}
};
__device__ __forceinline__ unsigned cvt_pk_bf16(float lo, float hi) { unsigned r; asm volatile("v_cvt_pk_bf16_f32 %0, %1, %2" : "=v"(r) : "v"(lo), "v"(hi)); return r; }

struct EpiProj {
    static constexpr bool PERM = true, AFTER_DRAIN = false; static constexpr int MIDK_T = -1;
    bf16_t* O;
    __device__ __forceinline__ void midk(f32x4 (&)[2][2][4][2], const Unit&, int, int, int, int) const {}
    __device__ __forceinline__ void operator()(const f32x4 (&acc)[2][2][4][2], const Unit& u, int wr, int wc, int fr, int fq) const {
        const int row0 = u.pm * BM + wr * 64 + fr, col0 = u.pn * BM + wc * 32 + 8 * fq;
#pragma unroll
        for (int ai = 0; ai < 2; ++ai)
#pragma unroll
            for (int m = 0; m < 4; ++m) { bf16_t* rowp = O + (size_t)(row0 + ai * HALF + m * 16) * PW + col0;
#pragma unroll
                for (int bj = 0; bj < 2; ++bj) { const f32x4 v0 = acc[ai][bj][m][0], v1 = acc[ai][bj][m][1];
                    u32x4 w; w.x = cvt_pk_bf16(v0[0], v0[1]); w.y = cvt_pk_bf16(v0[2], v0[3]); w.z = cvt_pk_bf16(v1[0], v1[1]); w.w = cvt_pk_bf16(v1[2], v1[3]);
                    *(u32x4*)(rowp + bj * HALF) = w; } }
    }
};
struct EpiMix {
    static constexpr bool PERM = true, AFTER_DRAIN = false; static constexpr int MIDK_T = 16;
    const float* x; const float* mod; const float* g2n; const float* ssna; float* X1; bf16_t* A2; float* ss1;
    __device__ __forceinline__ void midk(f32x4 (&acc)[2][2][4][2], const Unit& u, int wr, int wc, int fr, int fq) const {
        const int row0 = u.pm * BM + wr * 64 + fr;
#pragma unroll
        for (int ai = 0; ai < 2; ++ai)
#pragma unroll
            for (int m = 0; m < 4; ++m) { const float r = rsqrtf(ssna[row0 + ai * HALF + m * 16] * (1.f / 1024.f) + EPS);
#pragma unroll
                for (int bj = 0; bj < 2; ++bj)
#pragma unroll
                    for (int n = 0; n < 2; ++n) acc[ai][bj][m][n] *= r; }
    }
    __device__ __forceinline__ void operator()(const f32x4 (&acc)[2][2][4][2], const Unit& u, int wr, int wc, int fr, int fq) const {
        const int row0 = u.pm * BM + wr * 64 + fr, col0 = u.pn * BM + wc * 32 + 8 * fq, b = u.pm >> 3;
        const float* mb = mod + (size_t)b * 6 * D;
        f32x4 g1v[2][2], gmv[2][2];
#pragma unroll
        for (int bj = 0; bj < 2; ++bj)
#pragma unroll
            for (int n = 0; n < 2; ++n) { const int c = col0 + bj * HALF + 4 * n; g1v[bj][n] = *(const f32x4*)(mb + 2 * D + c);
                const f32x4 sc = *(const f32x4*)(mb + 4 * D + c), gn = *(const f32x4*)(g2n + c); gmv[bj][n] = gn * (sc + 1.0f); }
#pragma unroll
        for (int ai = 0; ai < 2; ++ai)
#pragma unroll
            for (int m = 0; m < 4; ++m) { const int row = row0 + ai * HALF + m * 16; const size_t off = (size_t)row * D + col0; float ss = 0.f;
#pragma unroll
                for (int bj = 0; bj < 2; ++bj) { f32x4 x1[2];
#pragma unroll
                    for (int n = 0; n < 2; ++n) { const f32x4 xv = *(const f32x4*)(x + off + bj * HALF + 4 * n); x1[n] = xv + g1v[bj][n] * acc[ai][bj][m][n];
                        *(f32x4*)(X1 + off + bj * HALF + 4 * n) = x1[n]; ss += (x1[n][0] * x1[n][0] + x1[n][1] * x1[n][1]) + (x1[n][2] * x1[n][2] + x1[n][3] * x1[n][3]); }
                    const f32x4 a0 = x1[0] * gmv[bj][0], a1 = x1[1] * gmv[bj][1];
                    u32x4 w; w.x = cvt_pk_bf16(a0[0], a0[1]); w.y = cvt_pk_bf16(a0[2], a0[3]); w.z = cvt_pk_bf16(a1[0], a1[1]); w.w = cvt_pk_bf16(a1[2], a1[3]);
                    *(u32x4*)(A2 + off + bj * HALF) = w; }
                ss += __shfl_xor(ss, 16); ss += __shfl_xor(ss, 32);
                if (fq == 0) atomicAdd(ss1 + row, ss); }
    }
};
struct EpiGU {
    static constexpr bool PERM = true, AFTER_DRAIN = false; static constexpr int MIDK_T = -1;
    const float* ss1; const float* bgu; bf16_t* ACT;
    __device__ __forceinline__ void midk(f32x4 (&)[2][2][4][2], const Unit&, int, int, int, int) const {}
    __device__ __forceinline__ void operator()(const f32x4 (&acc)[2][2][4][2], const Unit& u, int wr, int wc, int fr, int fq) const {
        const int row0 = u.pm * BM + wr * 64 + fr, colo = u.pn * HALF + wc * 32 + 8 * fq, b = u.pm >> 3;
        const float* bb = bgu + (size_t)b * 2 * DFF;
        f32x4 bg[2], bu[2];
#pragma unroll
        for (int n = 0; n < 2; ++n) { bg[n] = *(const f32x4*)(bb + colo + 4 * n); bu[n] = *(const f32x4*)(bb + DFF + colo + 4 * n); }
#pragma unroll
        for (int ai = 0; ai < 2; ++ai)
#pragma unroll
            for (int m = 0; m < 4; ++m) { const int row = row0 + ai * HALF + m * 16; const float rstd = rsqrtf(ss1[row] * (1.f / D) + EPS);
                float o[8];
#pragma unroll
                for (int n = 0; n < 2; ++n) { const f32x4 g = acc[ai][0][m][n] * rstd + bg[n], uu = acc[ai][1][m][n] * rstd + bu[n];
#pragma unroll
                    for (int j = 0; j < 4; ++j) o[4 * n + j] = silu_fast(g[j]) * uu[j]; }
                u32x4 w; w.x = cvt_pk_bf16(o[0], o[1]); w.y = cvt_pk_bf16(o[2], o[3]); w.z = cvt_pk_bf16(o[4], o[5]); w.w = cvt_pk_bf16(o[6], o[7]);
                *(u32x4*)(ACT + (size_t)row * DFF + colo) = w; }
    }
};
struct EpiDown {
    static constexpr bool PERM = true, AFTER_DRAIN = false; static constexpr int MIDK_T = -1;
    const float* X1; const float* mod; float* X2; float* ss2;
    __device__ __forceinline__ void midk(f32x4 (&)[2][2][4][2], const Unit&, int, int, int, int) const {}
    __device__ __forceinline__ void operator()(const f32x4 (&acc)[2][2][4][2], const Unit& u, int wr, int wc, int fr, int fq) const {
        const int row0 = u.pm * BM + wr * 64 + fr, col0 = u.pn * BM + wc * 32 + 8 * fq, b = u.pm >> 3;
        const float* mb = mod + (size_t)b * 6 * D + 5 * D;
        f32x4 g2v[2][2];
#pragma unroll
        for (int bj = 0; bj < 2; ++bj)
#pragma unroll
            for (int n = 0; n < 2; ++n) g2v[bj][n] = *(const f32x4*)(mb + col0 + bj * HALF + 4 * n);
#pragma unroll
        for (int ai = 0; ai < 2; ++ai)
#pragma unroll
            for (int m = 0; m < 4; ++m) { const int row = row0 + ai * HALF + m * 16; const size_t off = (size_t)row * D + col0; float ss = 0.f;
#pragma unroll
                for (int bj = 0; bj < 2; ++bj)
#pragma unroll
                    for (int n = 0; n < 2; ++n) { const f32x4 xv = *(const f32x4*)(X1 + off + bj * HALF + 4 * n); const f32x4 x2 = xv + g2v[bj][n] * acc[ai][bj][m][n];
                        *(f32x4*)(X2 + off + bj * HALF + 4 * n) = x2; ss += (x2[0] * x2[0] + x2[1] * x2[1]) + (x2[2] * x2[2] + x2[3] * x2[3]); }
                ss += __shfl_xor(ss, 16); ss += __shfl_xor(ss, 32);
                if (fq == 0) atomicAdd(ss2 + row, ss); }
    }
};

template <class Epi, class Sched, bool ALIGN_EPI = false, bool SP2 = false>
__device__ __forceinline__ void gemm_phase(PG8_LAS unsigned char* lds, const Gemm g, const Sched& S, const Epi& E) {
    const int tid = threadIdx.x, wid = __builtin_amdgcn_readfirstlane(tid >> 6), lane = tid & 63, wr = wid >> 2, wc = wid & 3, fr = lane & 15, fq = lane >> 4;
    const int K = g.K, nt = K / BK;
    unsigned voffA[2], voffB[2];
#pragma unroll
    for (int i = 0; i < 2; ++i) { int R, C; stage_rc(tid * 16 + i * 8192, R, C); const int Rb = Epi::PERM ? ((R & ~31) + perm32(R & 31)) : R;
        voffA[i] = (unsigned)(R * K + C) * 2u; voffB[i] = (unsigned)(Rb * K + C) * 2u; }
    const size_t kstep = (size_t)(BK * 2);
    const size_t hstep = (size_t)HALF * K * 2;
    const size_t tstep = 2 * hstep;
    const unsigned ldsw = (unsigned)wid * 1024u;
    const int aoff = lds_byte(wr * 64 + fr, fq * 8), boff = lds_byte(wc * 32 + fr, fq * 8);
#define PG8_SA(b, h) (((b) * 2 + (h)) * HTB)
#define PG8_SB(b, h) ((4 + (b) * 2 + (h)) * HTB)
#define PG8_STAGE(bufoff, gbase, voff) do { _Pragma("unroll") for (int _i = 0; _i < 2; ++_i) \
        __builtin_amdgcn_global_load_lds((const unsigned*)((const char*)(gbase) + (voff)[_i]), (PG8_LAS unsigned*)(lds + (bufoff) + ldsw + _i * 8192), 16, 0, 0); } while (0)
#define PG8_LDA(dst, b, h) do { _Pragma("unroll") for (int m = 0; m < 4; ++m) _Pragma("unroll") for (int k = 0; k < 2; ++k) dst[m][k] = *(const PG8_LAS bf16x8*)(lds + PG8_SA(b, h) + aoff + m * 2048 + k * 1024); } while (0)
#define PG8_LDB(dst, b, h) do { _Pragma("unroll") for (int n = 0; n < 2; ++n) _Pragma("unroll") for (int k = 0; k < 2; ++k) dst[n][k] = *(const PG8_LAS bf16x8*)(lds + PG8_SB(b, h) + boff + n * 2048 + k * 1024); } while (0)
#define PG8_MMA(ai, bj, At, Bt) do { __builtin_amdgcn_s_setprio(1); _Pragma("unroll") for (int m = 0; m < 4; ++m) _Pragma("unroll") for (int n = 0; n < 2; ++n) _Pragma("unroll") for (int k = 0; k < 2; ++k) \
        acc[ai][bj][m][n] = __builtin_amdgcn_mfma_f32_16x16x32_bf16(Bt[n][k], At[m][k], acc[ai][bj][m][n], 0, 0, 0); __builtin_amdgcn_s_setprio(0); } while (0)
#define PG8_WAIT_V(n) asm volatile("s_waitcnt vmcnt(" #n ")" ::: "memory")
#define PG8_WAIT_L(n) asm volatile("s_waitcnt lgkmcnt(" #n ")" ::: "memory")
#define PG8_BAR __builtin_amdgcn_s_barrier()
#define PG8_SCHED __builtin_amdgcn_sched_barrier(0)
    Unit cur, nxt; int ui = 0;
    if (!S.next(0, cur)) return;
    f32x4 acc[2][2][4][2];
#pragma unroll
    for (int a = 0; a < 2; ++a)
#pragma unroll
        for (int b = 0; b < 2; ++b)
#pragma unroll
            for (int m = 0; m < 4; ++m)
#pragma unroll
                for (int n = 0; n < 2; ++n) acc[a][b][m][n] = (f32x4){0.f, 0.f, 0.f, 0.f};
    bf16x8 At[4][2], B0[2][2], B1[2][2];
    const char* cA = (const char*)g.A + (size_t)cur.pm * tstep; const char* cB = (const char*)g.Bt + (size_t)cur.pn * tstep;
    S.a_ready(cur);
    if constexpr (SP2) {
        PG8_STAGE(PG8_SB(0, 0), cB, voffB); PG8_STAGE(PG8_SB(0, 1), cB + hstep, voffB); PG8_STAGE(PG8_SA(0, 0), cA, voffA); PG8_STAGE(PG8_SA(0, 1), cA + hstep, voffA);
        if (wr == 1) PG8_BAR;
        PG8_WAIT_V(2); PG8_BAR;
        PG8_STAGE(PG8_SB(1, 0), cB + kstep, voffB); PG8_STAGE(PG8_SA(1, 0), cA + kstep, voffA); PG8_STAGE(PG8_SB(1, 1), cB + hstep + kstep, voffB);
        PG8_WAIT_V(6); PG8_BAR;
    } else {
        PG8_STAGE(PG8_SB(0, 0), cB, voffB); PG8_STAGE(PG8_SA(0, 0), cA, voffA); PG8_STAGE(PG8_SB(0, 1), cB + hstep, voffB); PG8_STAGE(PG8_SA(0, 1), cA + hstep, voffA);
        if (wr == 1) PG8_BAR;
        PG8_WAIT_V(4); PG8_BAR;
        PG8_STAGE(PG8_SB(1, 0), cB + kstep, voffB); PG8_STAGE(PG8_SA(1, 0), cA + kstep, voffA); PG8_STAGE(PG8_SB(1, 1), cB + hstep + kstep, voffB);
        PG8_WAIT_V(6); PG8_BAR;
    }
    for (;;) {
        const bool has_next = S.next(ui + 1, nxt);
        const char* nA = has_next ? (const char*)g.A + (size_t)nxt.pm * tstep : cA; const char* nB = has_next ? (const char*)g.Bt + (size_t)nxt.pn * tstep : cB;
        for (int t = 0; t < nt; t += 2) {
            if constexpr (Epi::MIDK_T >= 0) { if (t == Epi::MIDK_T) E.midk(acc, cur, wr, wc, fr, fq); }
            const bool last = (t == nt - 2);
            const char* a1 = cA + (size_t)(t + 1) * kstep;
            const char* a2 = last ? nA : cA + (size_t)(t + 2) * kstep; const char* b2 = last ? nB : cB + (size_t)(t + 2) * kstep;
            const char* a3 = a2 + kstep; const char* b3 = b2 + kstep;
            if (last && has_next) S.a_ready(nxt);
            if constexpr (SP2) {
            PG8_LDB(B0, 0, 0); PG8_LDB(B1, 0, 1); PG8_SCHED; PG8_LDA(At, 0, 0); PG8_STAGE(PG8_SA(1, 1), a1 + hstep, voffA);
            PG8_WAIT_V(8); PG8_WAIT_L(0); PG8_BAR; PG8_MMA(0, 0, At, B0); PG8_MMA(0, 1, At, B1); PG8_BAR; PG8_SCHED;
            PG8_LDA(At, 0, 1); PG8_STAGE(PG8_SB(0, 0), b2, voffB); PG8_STAGE(PG8_SB(0, 1), b2 + hstep, voffB); PG8_STAGE(PG8_SA(0, 0), a2, voffA);
            PG8_WAIT_V(8); PG8_WAIT_L(0); PG8_BAR; PG8_MMA(1, 0, At, B0); PG8_MMA(1, 1, At, B1); PG8_BAR; PG8_SCHED;
            PG8_LDB(B0, 1, 0); PG8_LDB(B1, 1, 1); PG8_SCHED; PG8_LDA(At, 1, 0); PG8_STAGE(PG8_SA(0, 1), a2 + hstep, voffA);
            PG8_WAIT_V(8); PG8_WAIT_L(0); PG8_BAR; PG8_MMA(0, 0, At, B0); PG8_MMA(0, 1, At, B1); PG8_BAR; PG8_SCHED;
            PG8_LDA(At, 1, 1); PG8_STAGE(PG8_SB(1, 0), b3, voffB); PG8_STAGE(PG8_SB(1, 1), b3 + hstep, voffB); PG8_STAGE(PG8_SA(1, 0), a3, voffA);
            PG8_WAIT_V(8); PG8_WAIT_L(0); PG8_BAR; PG8_MMA(1, 0, At, B0); PG8_MMA(1, 1, At, B1); PG8_BAR; PG8_SCHED;
            } else {
            PG8_LDB(B0, 0, 0); PG8_SCHED; PG8_LDA(At, 0, 0); PG8_STAGE(PG8_SA(1, 1), a1 + hstep, voffA);
            PG8_WAIT_L(8); PG8_BAR; PG8_WAIT_L(0); PG8_MMA(0, 0, At, B0); PG8_BAR; PG8_SCHED;
            PG8_LDB(B1, 0, 1); PG8_STAGE(PG8_SB(0, 0), b2, voffB);
            PG8_BAR; PG8_WAIT_L(0); PG8_MMA(0, 1, At, B1); PG8_BAR;
            PG8_LDA(At, 0, 1); PG8_STAGE(PG8_SA(0, 0), a2, voffA);
            PG8_BAR; PG8_WAIT_L(0); PG8_MMA(1, 0, At, B0); PG8_BAR; PG8_SCHED;
            PG8_STAGE(PG8_SB(0, 1), b2 + hstep, voffB);
            PG8_WAIT_V(6); PG8_BAR; PG8_MMA(1, 1, At, B1); PG8_BAR;
            PG8_LDB(B0, 1, 0); PG8_SCHED; PG8_LDA(At, 1, 0); PG8_STAGE(PG8_SA(0, 1), a2 + hstep, voffA);
            PG8_WAIT_L(8); PG8_BAR; PG8_WAIT_L(0); PG8_MMA(0, 0, At, B0); PG8_BAR; PG8_SCHED;
            PG8_LDB(B1, 1, 1); PG8_STAGE(PG8_SB(1, 0), b3, voffB);
            PG8_BAR; PG8_WAIT_L(0); PG8_MMA(0, 1, At, B1); PG8_BAR;
            PG8_LDA(At, 1, 1); PG8_STAGE(PG8_SA(1, 0), a3, voffA);
            PG8_BAR; PG8_WAIT_L(0); PG8_MMA(1, 0, At, B0); PG8_BAR; PG8_SCHED;
            PG8_STAGE(PG8_SB(1, 1), b3 + hstep, voffB);
            PG8_WAIT_V(6); PG8_BAR; PG8_MMA(1, 1, At, B1); PG8_BAR;
            }
        }
        if constexpr (ALIGN_EPI) { if (wr == 0) PG8_BAR; }
        if constexpr (!Epi::AFTER_DRAIN) { E(acc, cur, wr, wc, fr, fq); S.done(cur); }
        if (!has_next) break;
#pragma unroll
        for (int a = 0; a < 2; ++a)
#pragma unroll
            for (int b = 0; b < 2; ++b)
#pragma unroll
                for (int m = 0; m < 4; ++m)
#pragma unroll
                    for (int n = 0; n < 2; ++n) acc[a][b][m][n] = (f32x4){0.f, 0.f, 0.f, 0.f};
        cur = nxt; cA = nA; cB = nB; ++ui;
        if constexpr (ALIGN_EPI) { if (wr == 1) PG8_BAR; }
    }
    PG8_WAIT_V(0);
    if constexpr (!ALIGN_EPI) { if (wr == 0) PG8_BAR; }
    PG8_BAR;
    if constexpr (Epi::AFTER_DRAIN) { E.fused(acc, cur, wr, wc, fr, fq, lds, wid, lane); S.done(cur); }
#undef PG8_SA
#undef PG8_SB
#undef PG8_STAGE
#undef PG8_LDA
#undef PG8_LDB
#undef PG8_MMA
#undef PG8_WAIT_V
#undef PG8_WAIT_L
#undef PG8_BAR
#undef PG8_SCHED
}
}

constexpr int NWAVES = 8;
constexpr int RING_OFF = 0, RING_BYTES = 131072;
constexpr int LDS_BYTES = 147456;
constexpr int LDSCTL_OFF = LDS_BYTES - 512, MISC_OFF = LDSCTL_OFF + 320;
#define GAS __attribute__((address_space(1)))
#define LAS __attribute__((address_space(3)))
typedef unsigned v4u __attribute__((ext_vector_type(4)));
typedef float f32x4 __attribute__((ext_vector_type(4)));
typedef short bf16x8 __attribute__((ext_vector_type(8)));
typedef GAS unsigned gu32;
#define RLX_AGENT __ATOMIC_RELAXED, __HIP_MEMORY_SCOPE_AGENT
#define LDS_WAIT() asm volatile("s_waitcnt lgkmcnt(0)" ::: "memory")
#define VM_WAIT() asm volatile("s_waitcnt vmcnt(0)" ::: "memory")

#define XB_TMO      128
#define XB_XCNT(j)  (256  + 64 * (j))
#define XB_XSUB(j)  (1280 + 64 * (j))
#define XB_XGEN(j)  (2304 + 64 * (j))
#define XB_TOP      3328
#define XB_TOPGEN   3392
#define XCD_BAR_WORDS 3456
#define XB_SPIN_CAP (1u << 18)

__device__ __forceinline__ unsigned xb_ld(unsigned* p)              { return __hip_atomic_load(p, __ATOMIC_RELAXED, __HIP_MEMORY_SCOPE_AGENT); }
__device__ __forceinline__ unsigned xb_add(unsigned* p, unsigned v) { return __hip_atomic_fetch_add(p, v, __ATOMIC_RELAXED, __HIP_MEMORY_SCOPE_AGENT); }
__device__ __forceinline__ unsigned xb_xcc_id() { return (unsigned)__builtin_amdgcn_s_getreg((3 << 11) | 20) & 0xFu; }
#define XB_SPIN(cond, bar) do { unsigned _sp = 0; while (cond) { __builtin_amdgcn_s_sleep(1); \
    if ((++_sp & 255u) == 0u) { if (xb_ld(&(bar)[XB_TMO])) break; if (_sp > XB_SPIN_CAP) { atomicAdd(&(bar)[XB_TMO], 1u); break; } } } } while (0)

struct XcdBarrier {
    unsigned* bar; unsigned x;
    volatile LAS unsigned* st;
};

__device__ __forceinline__ XcdBarrier xcd_barrier_post(unsigned* bar, volatile LAS unsigned* st) {
    XcdBarrier b; b.bar = bar; b.x = xb_xcc_id(); b.st = st;
    if (threadIdx.x == 0) (void)xb_add(&bar[XB_XCNT(b.x)], 1u);
    return b;
}
__device__ __forceinline__ void xcd_barrier_complete(unsigned* bar, unsigned x, unsigned& nloc, unsigned& nx) {
    const unsigned G = gridDim.x * gridDim.y * gridDim.z;
    unsigned sum, cnt, mine, sp = 0u;
    for (;;) {
        sum = 0u; cnt = 0u; mine = 0u;
#pragma unroll
        for (unsigned j = 0; j < 16; ++j) { const unsigned c = xb_ld(&bar[XB_XCNT(j)]); sum += c; cnt += (c > 0u) ? 1u : 0u; mine = (j == x) ? c : mine; }
        if (sum == G) break;
        __builtin_amdgcn_s_sleep(1);
        if ((++sp & 255u) == 0u) { if (xb_ld(&bar[XB_TMO])) break; if (sp > XB_SPIN_CAP) { atomicAdd(&bar[XB_TMO], 1u); break; } }
    }
    nloc = mine > 0u ? mine : 1u; nx = cnt > 0u ? cnt : 1u;
}

__device__ __forceinline__ void xcd_barrier(const XcdBarrier& b) {
    asm volatile("s_waitcnt vmcnt(0)" ::: "memory");
    __syncthreads();
    if (threadIdx.x == 0) {
        unsigned* bar = b.bar;
        __builtin_amdgcn_s_waitcnt(0);
        unsigned nloc = b.st[0], nx = b.st[1];
        if (nloc == 0u) { xcd_barrier_complete(bar, b.x, nloc, nx); b.st[0] = nloc; b.st[1] = nx; }
        const unsigned old = xb_add(&bar[XB_XSUB(b.x)], 1u);
        const unsigned gen = old / nloc;
        if (old + 1u == (gen + 1u) * nloc) {
            __builtin_amdgcn_fence(__ATOMIC_RELEASE, "agent");
            asm volatile("s_waitcnt vmcnt(0)" ::: "memory");
            const unsigned og = xb_add(&bar[XB_TOP], 1u);
            const unsigned tg = og / nx;
            if (og + 1u == (tg + 1u) * nx) xb_add(&bar[XB_TOPGEN], 1u);
            else XB_SPIN(xb_ld(&bar[XB_TOPGEN]) == tg, bar);
            __builtin_amdgcn_fence(__ATOMIC_ACQUIRE, "agent");
            xb_add(&bar[XB_XGEN(b.x)], 1u);
            asm volatile("s_waitcnt vmcnt(0)" ::: "memory");
        } else {
            XB_SPIN(xb_ld(&bar[XB_XGEN(b.x)]) == gen, bar);
            __builtin_amdgcn_fence(__ATOMIC_ACQUIRE, "agent");
            asm volatile("s_waitcnt vmcnt(0)" ::: "memory");
        }
    }
    __syncthreads();
}

struct Frame {
    LAS unsigned char* lds;
    volatile LAS unsigned* MISC;
    gu32* ctl;
    int tid, lane, wave;
    int vcu, G;
};

__device__ __forceinline__ float wave_sum(float v) {
#pragma unroll
    for (int o = 1; o < 64; o <<= 1) v += __shfl_xor(v, o);
    return v;
}

template <int MODE, int SCALE>
__device__ __forceinline__ void p0_transpose_item(const float* W, int K, int N, bf16_t* WT, LAS float* scr, int item, int lane) {
    const int nblk = N / 32, kb = item / nblk, nb = item % nblk, k0 = 64 * kb, n0 = 32 * nb;
#pragma unroll 8
    for (int i = 0; i < 32; ++i) { const int kk = 2 * i + (lane >> 5); scr[kk * 33 + (lane & 31)] = W[(size_t)(k0 + kk) * N + n0 + (lane & 31)]; }
    LDS_WAIT(); asm volatile("" ::: "memory");
    float sc = 1.f; if (SCALE) sc = (n0 < 1024) ? C_NA : ((n0 >= O_DAQ && n0 < O_DAK) ? C_DA : 1.f);
    const int row0 = MODE == 0 ? n0 : ((n0 >> 7) * 256 + (MODE == 2 ? 128 : 0) + (n0 & 127));
    const int c = lane & 7;
#pragma unroll
    for (int j = 0; j < 4; ++j) { const int n = (lane >> 3) + 8 * j; const LAS float* s = scr + (8 * c) * 33 + n;
        v4u o; o.x = pk2(s[0 * 33] * sc, s[1 * 33] * sc); o.y = pk2(s[2 * 33] * sc, s[3 * 33] * sc); o.z = pk2(s[4 * 33] * sc, s[5 * 33] * sc); o.w = pk2(s[6 * 33] * sc, s[7 * 33] * sc);
        *(GAS v4u*)(WT + (size_t)(row0 + n) * K + k0 + 8 * c) = o; }
    LDS_WAIT(); asm volatile("" ::: "memory");
}
__device__ __forceinline__ void p0_ada_task(const float* c, const float* w_ada, const float* b_ada, float* modacc, LAS float* scr, int t, int lane) {
    const int ng = t >> 5, kc = t & 31, n0 = ng * 256 + 4 * lane, k0 = kc * 64;
    float csv[4];
#pragma unroll
    for (int b = 0; b < 4; ++b) csv[b] = silu_f(c[b * D + k0 + lane]);
    f32x4 acc[4];
#pragma unroll
    for (int b = 0; b < 4; ++b) acc[b] = (f32x4){0.f, 0.f, 0.f, 0.f};
    const float* wp = w_ada + (size_t)k0 * (6 * D) + n0;
#pragma unroll 8
    for (int k = 0; k < 64; ++k) { const f32x4 w = *(const f32x4*)(wp + (size_t)k * (6 * D));
#pragma unroll
        for (int b = 0; b < 4; ++b) { const float s = __int_as_float(__builtin_amdgcn_readlane(__float_as_int(csv[b]), k)); acc[b] += w * s; } }
    if (kc == 0) { const f32x4 bb = *(const f32x4*)(b_ada + n0);
#pragma unroll
        for (int b = 0; b < 4; ++b) acc[b] += bb; }
#pragma unroll
    for (int b = 0; b < 4; ++b) *(LAS f32x4*)(scr + b * 256 + 4 * lane) = acc[b];
    LDS_WAIT(); asm volatile("" ::: "memory");
#pragma unroll
    for (int b = 0; b < 4; ++b)
#pragma unroll
        for (int j = 0; j < 4; ++j) atomicAdd(modacc + (size_t)b * 6 * D + ng * 256 + lane + 64 * j, scr[b * 256 + lane + 64 * j]);
    LDS_WAIT(); asm volatile("" ::: "memory");
}
struct P0Args { const float *c, *w_ada, *b_ada, *w_in, *w_out, *w_gate, *w_up, *w_down; float* modacc; bf16_t *Win_t, *Wout_t, *Wgu_t, *Wd_t; };
__device__ __forceinline__ void p0a_phase(Frame& F, const P0Args& a) {
    LAS float* scr = (LAS float*)(F.lds + RING_OFF + F.wave * 16384);
    if (F.wave < 6) { const int t = F.vcu * 6 + F.wave; if (t < 1536) p0_ada_task(a.c, a.w_ada, a.b_ada, a.modacc, scr, t, F.lane); }
    const int gw = F.vcu * NWAVES + F.wave, NGW = F.G * NWAVES;
    constexpr int I_IN = (D / 64) * (PW / 32), I_OUT = (D / 64) * (D / 32), I_G = (D / 64) * (DFF / 32), I_D = (DFF / 64) * (D / 32);
    constexpr int NITEMS = I_IN + I_OUT + 2 * I_G + I_D;
    for (int it = gw; it < NITEMS; it += NGW) {
        int r = it;
        if (r < I_IN) { p0_transpose_item<0, 1>(a.w_in, D, PW, a.Win_t, scr, r, F.lane); continue; } r -= I_IN;
        if (r < I_OUT) { p0_transpose_item<0, 0>(a.w_out, D, D, a.Wout_t, scr, r, F.lane); continue; } r -= I_OUT;
        if (r < I_G) { p0_transpose_item<1, 0>(a.w_gate, D, DFF, a.Wgu_t, scr, r, F.lane); continue; } r -= I_G;
        if (r < I_G) { p0_transpose_item<2, 0>(a.w_up, D, DFF, a.Wgu_t, scr, r, F.lane); continue; } r -= I_G;
        p0_transpose_item<0, 0>(a.w_down, DFF, D, a.Wd_t, scr, r, F.lane);
    }
}
__device__ __forceinline__ void p0b_phase(Frame& F, const float* x, const float* mod, const float* g1n, bf16_t* H, const bf16_t* Wgu_t, float* bgu) {
    const int gw = F.vcu * NWAVES + F.wave, NGW = F.G * NWAVES;
    for (int m = gw; m < M; m += NGW) {
        const int b = m / SEQ; const float* mb = mod + (size_t)b * 6 * D;
        const GAS f32x4* xr = (const GAS f32x4*)(x + (size_t)m * D) + F.lane;
        f32x4 v[8]; float s = 0.f;
#pragma unroll
        for (int j = 0; j < 8; ++j) { v[j] = xr[64 * j]; s += (v[j].x * v[j].x + v[j].y * v[j].y) + (v[j].z * v[j].z + v[j].w * v[j].w); }
        const float rstd = rsqrtf(wave_sum(s) * (1.f / D) + EPS);
        GAS unsigned long long* o8 = (GAS unsigned long long*)(H + (size_t)m * D) + F.lane;
#pragma unroll
        for (int j = 0; j < 8; ++j) { const int col = 4 * F.lane + 256 * j;
            const f32x4 sh = *(const f32x4*)(mb + col), sc = *(const f32x4*)(mb + D + col), gn = *(const f32x4*)(g1n + col);
            const f32x4 h = v[j] * rstd * gn * (sc + 1.0f) + sh;
            o8[64 * j] = (unsigned long long)pk2(h.x, h.y) | ((unsigned long long)pk2(h.z, h.w) << 32); }
    }
    LAS float* sh2s = (LAS float*)(F.lds + RING_OFF);
    for (int i = F.tid; i < 4 * D; i += NWAVES * 64) { const int b = i / D, k = i % D; sh2s[i] = mod[(size_t)b * 6 * D + 3 * D + k]; }
    __syncthreads();
    for (int nn = gw; nn < 2 * DFF; nn += NGW) {
        const int cc = nn < DFF ? nn : nn - DFF; const int row = (cc >> 7) * 256 + (nn < DFF ? 0 : 128) + (cc & 127);
        const GAS v4u* wr = (const GAS v4u*)(Wgu_t + (size_t)row * D) + F.lane;
        float a[4] = {0.f, 0.f, 0.f, 0.f};
#pragma unroll
        for (int j = 0; j < 4; ++j) { const v4u w = wr[64 * j]; const int k = 8 * (F.lane + 64 * j);
            float wf[8]; wf[0] = __uint_as_float(w.x << 16); wf[1] = __uint_as_float(w.x & 0xffff0000u); wf[2] = __uint_as_float(w.y << 16); wf[3] = __uint_as_float(w.y & 0xffff0000u);
            wf[4] = __uint_as_float(w.z << 16); wf[5] = __uint_as_float(w.z & 0xffff0000u); wf[6] = __uint_as_float(w.w << 16); wf[7] = __uint_as_float(w.w & 0xffff0000u);
#pragma unroll
            for (int b = 0; b < 4; ++b) { const f32x4 s0 = *(const LAS f32x4*)(sh2s + b * D + k), s1 = *(const LAS f32x4*)(sh2s + b * D + k + 4);
                a[b] += (wf[0] * s0.x + wf[1] * s0.y) + (wf[2] * s0.z + wf[3] * s0.w) + (wf[4] * s1.x + wf[5] * s1.y) + (wf[6] * s1.z + wf[7] * s1.w); } }
#pragma unroll
        for (int b = 0; b < 4; ++b) { const float t = wave_sum(a[b]); if (F.lane == 0) bgu[(size_t)b * 2 * DFF + nn] = t; }
    }
    __syncthreads();
}
__device__ __forceinline__ void p6_phase(Frame& F, float* out, const float* ss2, const float* fg) {
    const int gw = F.vcu * NWAVES + F.wave, NGW = F.G * NWAVES;
    for (int m = gw; m < M; m += NGW) {
        const float rstd = rsqrtf(ss2[m] * (1.f / D) + EPS);
        GAS f32x4* xr = (GAS f32x4*)(out + (size_t)m * D) + F.lane;
#pragma unroll
        for (int j = 0; j < 8; ++j) { const f32x4 gn = *(const f32x4*)(fg + 4 * F.lane + 256 * j); xr[64 * j] = xr[64 * j] * rstd * gn; }
    }
}


namespace att {
using bf16x8 = __attribute__((ext_vector_type(8))) short;
using s16x4  = __attribute__((ext_vector_type(4))) short;
using f32x16 = __attribute__((ext_vector_type(16))) float;
using u32x4  = __attribute__((ext_vector_type(4))) unsigned;
using f32x4  = __attribute__((ext_vector_type(4))) float;
#define ALAS __attribute__((address_space(3)))
#define SBAR() __builtin_amdgcn_sched_barrier(0)
constexpr int QBLK = 32, KVBLK = 64, NW = 8;
#ifndef ATT_SDEPTH
#define ATT_SDEPTH 1
#endif
constexpr float THR = 4.f;
constexpr int SHM_V = KVBLK * 128 * 2;
constexpr int L_V = 0, L_K = 2 * SHM_V, L_WS = L_K + 2 * 16384, L_LUT = L_WS + NW * 64 * 4, L_MISC = L_LUT + 4096, L_Q = L_MISC + 256, QPITCH = 272, L_END = L_Q + 256 * QPITCH;
__device__ __forceinline__ int crow(int r, int hi) { return (r & 3) + 8 * (r >> 2) + 4 * hi; }
__device__ __forceinline__ unsigned cvtpk(float lo, float hi) { unsigned r; asm volatile("v_cvt_pk_bf16_f32 %0, %1, %2" : "=v"(r) : "v"(lo), "v"(hi)); return r; }
template <int DQK> __device__ __forceinline__ int kswz(int row, int colB) {
    if (DQK == 128) return row * 256 + (colB ^ ((row & 7) << 4));
    return row * 128 + (colB ^ (((row >> 1) & 7) << 4));
}
__device__ __forceinline__ int v_st(int k, int c) { const int kk = (k & ~0xC) | ((k & 4) << 1) | ((k & 8) >> 1); return ((kk >> 3) * 4 + (c >> 5)) * 512 + ((kk & 7) * 32 + (c & 31)) * 2; }
__device__ __forceinline__ int v_rd_base(int lane) { return ((lane & 3) << 3) | (((lane >> 2) & 3) << 6) | (((lane >> 4) & 1) << 5) | (((lane >> 5) & 1) << 8); }
constexpr int v_rd_off(int d0, int ks, int half) { return d0 * 512 + ks * 4096 + half * 2048; }
template <int OFF> __device__ __forceinline__ s16x4 tr_read(int vb) {
    s16x4 r; asm volatile("ds_read_b64_tr_b16 %0, %1 offset:%2" : "=&v"(r) : "v"(vb), "i"(OFF) : "memory"); return r;
}
template <int D0> __device__ __forceinline__ void pv_one(f32x16& od, int vb, bf16x8 pa0, bf16x8 pa1, bf16x8 pa2, bf16x8 pa3) {
    const s16x4 l0 = tr_read<v_rd_off(D0, 0, 0)>(vb), h0 = tr_read<v_rd_off(D0, 0, 1)>(vb), l1 = tr_read<v_rd_off(D0, 1, 0)>(vb), h1 = tr_read<v_rd_off(D0, 1, 1)>(vb);
    const s16x4 l2 = tr_read<v_rd_off(D0, 2, 0)>(vb), h2 = tr_read<v_rd_off(D0, 2, 1)>(vb), l3 = tr_read<v_rd_off(D0, 3, 0)>(vb), h3 = tr_read<v_rd_off(D0, 3, 1)>(vb);
    asm volatile("s_waitcnt lgkmcnt(0)" ::: "memory"); SBAR();
#define PK(L, H) (bf16x8){L[0], L[1], L[2], L[3], H[0], H[1], H[2], H[3]}
    od = __builtin_amdgcn_mfma_f32_32x32x16_bf16(pa0, PK(l0, h0), od, 0, 0, 0);
    od = __builtin_amdgcn_mfma_f32_32x32x16_bf16(pa1, PK(l1, h1), od, 0, 0, 0);
    od = __builtin_amdgcn_mfma_f32_32x32x16_bf16(pa2, PK(l2, h2), od, 0, 0, 0);
    od = __builtin_amdgcn_mfma_f32_32x32x16_bf16(pa3, PK(l3, h3), od, 0, 0, 0);
#undef PK
}
__device__ __forceinline__ void pv_d0(f32x16* o, int vb, bf16x8 pa0, bf16x8 pa1, bf16x8 pa2, bf16x8 pa3) {
    pv_one<0>(o[0], vb, pa0, pa1, pa2, pa3); pv_one<1>(o[1], vb, pa0, pa1, pa2, pa3); pv_one<2>(o[2], vb, pa0, pa1, pa2, pa3); pv_one<3>(o[3], vb, pa0, pa1, pa2, pa3);
}
__device__ __forceinline__ void partialSM(f32x16& p0, f32x16& p1, float& m_reg, float& alpha) {
    float pmax = p0[0];
#pragma unroll
    for (int r = 1; r < 16; ++r) pmax = fmaxf(pmax, p0[r]);
#pragma unroll
    for (int r = 0; r < 16; ++r) pmax = fmaxf(pmax, p1[r]);
    { auto rr = __builtin_amdgcn_permlane32_swap(__float_as_uint(pmax), __float_as_uint(pmax), false, false);
      pmax = fmaxf(__uint_as_float(rr[0]), __uint_as_float(rr[1])); }
    float mn;
    if (__builtin_expect(__all(pmax - m_reg <= THR), 1)) { mn = m_reg; alpha = 1.f; }
    else { mn = fmaxf(m_reg, pmax); alpha = __builtin_amdgcn_exp2f(m_reg - mn); m_reg = mn; }
#pragma unroll
    for (int r = 0; r < 16; ++r) p0[r] = __builtin_amdgcn_exp2f(p0[r] - mn);
#pragma unroll
    for (int r = 0; r < 16; ++r) p1[r] -= mn;
}
__device__ __forceinline__ void finishSM(f32x16& p0, f32x16& p1, float alpha, float& l_reg, bf16x8& pa0, bf16x8& pa1, bf16x8& pa2, bf16x8& pa3) {
#pragma unroll
    for (int r = 0; r < 16; ++r) p1[r] = __builtin_amdgcn_exp2f(p1[r]);
    float ps = 0;
#pragma unroll
    for (int r = 0; r < 16; ++r) ps += p0[r];
#pragma unroll
    for (int r = 0; r < 16; ++r) ps += p1[r];
    { auto rr = __builtin_amdgcn_permlane32_swap(__float_as_uint(ps), __float_as_uint(ps), false, false);
      ps = __uint_as_float(rr[0]) + __uint_as_float(rr[1]); }
    l_reg = l_reg * alpha + ps;
#define PK4(P, BASE, OUT) do { unsigned a0 = cvtpk(P[BASE + 0], P[BASE + 1]), a1 = cvtpk(P[BASE + 2], P[BASE + 3]);   \
    unsigned b0 = cvtpk(P[BASE + 4], P[BASE + 5]), b1 = cvtpk(P[BASE + 6], P[BASE + 7]);                              \
    auto r0 = __builtin_amdgcn_permlane32_swap(a0, b0, false, false); auto r1 = __builtin_amdgcn_permlane32_swap(a1, b1, false, false); \
    u32x4 w = {r0[0], r1[0], r0[1], r1[1]}; OUT = *reinterpret_cast<bf16x8*>(&w); } while (0)
    PK4(p0, 0, pa0); PK4(p0, 8, pa1); PK4(p1, 0, pa2); PK4(p1, 8, pa3);
#undef PK4
}
template <int DQK, bool QLDS> __device__ __forceinline__ void qkt(f32x16& p0, f32x16& p1, const ALAS char* Ks, const bf16x8* qr, const ALAS char* qb, int r32, int hi) {
#pragma unroll
    for (int d0 = 0; d0 < DQK / 16; ++d0) { const int cb = (d0 * 16 + hi * 8) * 2; if (DQK == 128 && (d0 & 3) == 0 && d0) SBAR();
        const bf16x8 b0 = *reinterpret_cast<const ALAS bf16x8*>(Ks + kswz<DQK>(r32, cb));
        const bf16x8 b1 = *reinterpret_cast<const ALAS bf16x8*>(Ks + kswz<DQK>(32 + r32, cb));
        bf16x8 q; if (QLDS) q = *reinterpret_cast<const ALAS bf16x8*>(qb + d0 * 32); else q = qr[d0];
        p0 = __builtin_amdgcn_mfma_f32_32x32x16_bf16(b0, q, p0, 0, 0, 0);
        p1 = __builtin_amdgcn_mfma_f32_32x32x16_bf16(b1, q, p1, 0, 0, 0); }
}

struct DaBias {
    const ALAS float* lut; float cneg, cpos; int q0w, lbase;
    __device__ __forceinline__ void init(int j, f32x16& p0, f32x16& p1) const {
        const int k0 = j * KVBLK, rel_min = k0 - q0w - 31, rel_max = k0 + 63 - q0w;
        if (rel_min >= 91) {
#pragma unroll
            for (int r = 0; r < 16; ++r) { p0[r] = cpos; p1[r] = cpos; }
        } else if (rel_max <= -91) {
#pragma unroll
            for (int r = 0; r < 16; ++r) { p0[r] = cneg; p1[r] = cneg; }
        } else {
            const ALAS float* lp = lut + (k0 + lbase);
#pragma unroll
            for (int r = 0; r < 16; ++r) { p0[r] = lp[crow(r, 0)]; p1[r] = lp[32 + crow(r, 0)]; }
        }
    }
};
struct NaBias {
    const ALAS float* tab; int bs, rw, rsw, lbase; unsigned mask0, mask1;
    __device__ __forceinline__ void init(int j, f32x16& p0, f32x16& p1) const {
        const int kr = bs + j; const float NEG = -INFINITY;
        if (kr < rsw || kr >= rsw + 8) {
#pragma unroll
            for (int r = 0; r < 16; ++r) { p0[r] = NEG; p1[r] = NEG; }
        } else {
            const ALAS float* lp = tab + ((kr - rw + 7) * 32 + lbase);
#pragma unroll
            for (int r = 0; r < 16; ++r) { const float a = lp[crow(r, 0)]; p0[r] = ((mask0 >> r) & 1u) ? a : NEG; }
            SBAR();
#pragma unroll
            for (int r = 0; r < 16; ++r) { const float b = lp[32 + crow(r, 0)]; p1[r] = ((mask1 >> r) & 1u) ? b : NEG; }
        }
    }
};

__device__ __forceinline__ void v_inv(int P, int& k, int& c) { const int s = P >> 5, kk = (s >> 2) * 8 + ((P & 31) >> 2); c = (s & 3) * 32 + (P & 3) * 8; k = (kk & ~0xC) | ((kk & 4) << 1) | ((kk & 8) >> 1); }
template <int DQK> __device__ __forceinline__ void k_inv(int P, int& row, int& c) {
    if (DQK == 128) { row = P >> 4; c = ((P & 15) ^ (row & 7)) * 8; } else { row = P >> 3; c = ((P & 7) ^ ((row >> 1) & 7)) * 8; } }
template <int DQK, class Bias, bool QLDS>
__device__ __forceinline__ void attn_pass(const bf16_t* __restrict__ Qb, const bf16_t* __restrict__ Kh, const bf16_t* __restrict__ Vh, int NT, const Bias& B,
                                          ALAS char* lds, f32x16 (&o)[4], float& l_reg) {
    const int tid = threadIdx.x, wid = __builtin_amdgcn_readfirstlane(tid >> 6), lane = tid & 63, r32 = lane & 31, hi = lane >> 5;
    ALAS char* V_lds = lds + L_V; ALAS char* K_lds = lds + L_K; constexpr int SHM_K = KVBLK * DQK * 2, NKI = DQK / 64;
    ALAS float* ws = (ALAS float*)(lds + L_WS) + wid * 64; ALAS float* al_l = ws + 32;
    float m_reg = -1e30f; l_reg = 0.f;
#pragma unroll
    for (int d = 0; d < 4; ++d)
#pragma unroll
        for (int r = 0; r < 16; ++r) o[d][r] = 0.f;
    bf16x8 qr[QLDS ? 1 : DQK / 16]; const ALAS char* qb = lds + L_Q + (wid * QBLK + r32) * QPITCH + hi * 16;
    if (QLDS) {
        const char* Qt = (const char*)Qb; const unsigned qo = (unsigned)(((tid >> 4) * PW + (tid & 15) * 8) * 2);
#pragma unroll
        for (int i = 0; i < 8; ++i) { const bf16x8 v = *reinterpret_cast<const bf16x8*>(Qt + qo + (size_t)i * (32 * PW * 2));
            *reinterpret_cast<ALAS bf16x8*>(lds + L_Q + ((tid >> 4) + 32 * i) * QPITCH + (tid & 15) * 16) = v; }
    } else { const char* Qt = (const char*)(Qb + (size_t)(wid * QBLK) * PW); const unsigned qo = (unsigned)((r32 * PW + hi * 8) * 2);
#pragma unroll
        for (int d0 = 0; d0 < DQK / 16; ++d0) qr[d0] = *reinterpret_cast<const bf16x8*>(Qt + qo + d0 * 32); }
    const int vb0 = (int)(uintptr_t)V_lds + v_rd_base(lane);
    const char* Vt = (const char*)Vh; const char* Kt = (const char*)Kh;
    unsigned koff[NKI], voff[2];
#pragma unroll
    for (int i = 0; i < NKI; ++i) { int row, c; k_inv<DQK>((wid * NKI + i) * 64 + lane, row, c); koff[i] = (unsigned)((row * PW + c) * 2); }
#pragma unroll
    for (int i = 0; i < 2; ++i) { int k, c; v_inv((wid * 2 + i) * 64 + lane, k, c); voff[i] = (unsigned)((k * PW + c) * 2); }
#define DMA_K(b, k0) do { const char* kt_ = Kt + (size_t)(k0) * (PW * 2); _Pragma("unroll") for (int i_ = 0; i_ < NKI; ++i_) \
    __builtin_amdgcn_global_load_lds((const unsigned*)(kt_ + koff[i_]), (ALAS unsigned*)(K_lds + (b) * SHM_K + (wid * NKI + i_) * 1024), 16, 0, 0); } while (0)
#define DMA_V(b, k0) do { const char* vt_ = Vt + (size_t)(k0) * (PW * 2); _Pragma("unroll") for (int i_ = 0; i_ < 2; ++i_) \
    __builtin_amdgcn_global_load_lds((const unsigned*)(vt_ + voff[i_]), (ALAS unsigned*)(V_lds + (b) * SHM_V + (wid * 2 + i_) * 1024), 16, 0, 0); } while (0)
#define RESC(a) do { if (__any((a) < 1.f)) { if (hi == 0) al_l[r32] = (a); asm volatile("s_waitcnt lgkmcnt(0)" ::: "memory"); \
    _Pragma("unroll") for (int d = 0; d < 4; ++d) _Pragma("unroll") for (int r = 0; r < 16; ++r) o[d][r] *= al_l[crow(r, hi)]; } } while (0)
    f32x16 pA0, pA1, pB0, pB1; float alA, alB; bf16x8 pa0, pa1, pa2, pa3;
    DMA_K(0, 0); DMA_V(0, 0); DMA_K(1, KVBLK); DMA_V(1, KVBLK);
    __syncthreads();
    B.init(0, pA0, pA1); qkt<DQK, QLDS>(pA0, pA1, K_lds, qr, qb, r32, hi); partialSM(pA0, pA1, m_reg, alA);
    __syncthreads();
    for (int j = 1; j + 1 < NT; j += 2) {
        SBAR(); B.init(j, pB0, pB1); qkt<DQK, QLDS>(pB0, pB1, K_lds + SHM_K, qr, qb, r32, hi);
        finishSM(pA0, pA1, alA, l_reg, pa0, pa1, pa2, pa3); SBAR();
        DMA_K(0, (j + 1) * KVBLK); SBAR();
        pv_d0(o, vb0, pa0, pa1, pa2, pa3); partialSM(pB0, pB1, m_reg, alB);
        __syncthreads();
        DMA_V(0, (j + 1) * KVBLK); RESC(alB);
        SBAR(); B.init(j + 1, pA0, pA1); qkt<DQK, QLDS>(pA0, pA1, K_lds, qr, qb, r32, hi);
        finishSM(pB0, pB1, alB, l_reg, pa0, pa1, pa2, pa3); SBAR();
        DMA_K(1, (j + 2) * KVBLK); SBAR();
        pv_d0(o, vb0 + SHM_V, pa0, pa1, pa2, pa3); partialSM(pA0, pA1, m_reg, alA);
        __syncthreads();
        DMA_V(1, (j + 2) * KVBLK); RESC(alA);
    }
    SBAR(); B.init(NT - 1, pB0, pB1); qkt<DQK, QLDS>(pB0, pB1, K_lds + SHM_K, qr, qb, r32, hi);
    finishSM(pA0, pA1, alA, l_reg, pa0, pa1, pa2, pa3); SBAR();
    pv_d0(o, vb0, pa0, pa1, pa2, pa3); partialSM(pB0, pB1, m_reg, alB);
    __syncthreads();
    RESC(alB);
    finishSM(pB0, pB1, alB, l_reg, pa0, pa1, pa2, pa3); SBAR();
    pv_d0(o, vb0 + SHM_V, pa0, pa1, pa2, pa3);
    asm volatile("s_waitcnt vmcnt(0)" ::: "memory");
    __syncthreads();
#undef DMA_K
#undef DMA_V
#undef RESC
}
__device__ __forceinline__ void na_pass(const bf16_t* __restrict__ Qb, const bf16_t* __restrict__ Kh, const bf16_t* __restrict__ Vh, int NT, const NaBias& B,
                                        ALAS char* lds, f32x16 (&o)[4], float& l_reg) {
    constexpr int DQK = 128, SHM_K = KVBLK * DQK * 2;
    const int tid = threadIdx.x, wid = __builtin_amdgcn_readfirstlane(tid >> 6), lane = tid & 63, r32 = lane & 31, hi = lane >> 5;
    ALAS char* V_lds = lds + L_V; ALAS char* K_lds = lds + L_K;
    ALAS float* ws = (ALAS float*)(lds + L_WS) + wid * 64; ALAS float* al_l = ws + 32;
    float m_reg = -1e30f; l_reg = 0.f;
#pragma unroll
    for (int d = 0; d < 4; ++d)
#pragma unroll
        for (int r = 0; r < 16; ++r) o[d][r] = 0.f;
    const ALAS char* qb = lds + L_Q + (wid * QBLK + r32) * QPITCH + hi * 16;
    { const char* Qt = (const char*)Qb; const unsigned qo = (unsigned)(((tid >> 4) * PW + (tid & 15) * 8) * 2);
#pragma unroll
      for (int i = 0; i < 8; ++i) { const bf16x8 v = *reinterpret_cast<const bf16x8*>(Qt + qo + (size_t)i * (32 * PW * 2));
          *reinterpret_cast<ALAS bf16x8*>(lds + L_Q + ((tid >> 4) + 32 * i) * QPITCH + (tid & 15) * 16) = v; } }
    const int vb0 = (int)(uintptr_t)V_lds + v_rd_base(lane);
    const char* Vt = (const char*)Vh; const char* Kt = (const char*)Kh;
    unsigned koff[2], voff[2];
#pragma unroll
    for (int i = 0; i < 2; ++i) { int row, c; k_inv<DQK>((wid * 2 + i) * 64 + lane, row, c); koff[i] = (unsigned)((row * PW + c) * 2); }
#pragma unroll
    for (int i = 0; i < 2; ++i) { int k, c; v_inv((wid * 2 + i) * 64 + lane, k, c); voff[i] = (unsigned)((k * PW + c) * 2); }
#define DMA_KV(b, k0) do { const char* kt_ = Kt + (size_t)(k0) * (PW * 2); const char* vt_ = Vt + (size_t)(k0) * (PW * 2); _Pragma("unroll") for (int i_ = 0; i_ < 2; ++i_) { \
    __builtin_amdgcn_global_load_lds((const unsigned*)(kt_ + koff[i_]), (ALAS unsigned*)(K_lds + (b) * SHM_K + (wid * 2 + i_) * 1024), 16, 0, 0); \
    __builtin_amdgcn_global_load_lds((const unsigned*)(vt_ + voff[i_]), (ALAS unsigned*)(V_lds + (b) * SHM_V + (wid * 2 + i_) * 1024), 16, 0, 0); } } while (0)
    DMA_KV(0, 0); DMA_KV(1, KVBLK);
    __syncthreads();
    for (int j = 0; j < NT; ++j) {
        const int buf = j & 1, kr = B.bs + j;
        if (kr >= B.rsw && kr < B.rsw + 8) {
            f32x16 p0, p1; float al; bf16x8 pa0, pa1, pa2, pa3;
            B.init(j, p0, p1); SBAR();
            qkt<DQK, true>(p0, p1, K_lds + buf * SHM_K, nullptr, qb, r32, hi);
            partialSM(p0, p1, m_reg, al);
            if (__any(al < 1.f)) { if (hi == 0) al_l[r32] = al; asm volatile("s_waitcnt lgkmcnt(0)" ::: "memory");
#pragma unroll
                for (int d = 0; d < 4; ++d)
#pragma unroll
                    for (int r = 0; r < 16; ++r) o[d][r] *= al_l[crow(r, hi)]; }
            finishSM(p0, p1, al, l_reg, pa0, pa1, pa2, pa3); SBAR();
            pv_d0(o, vb0 + buf * SHM_V, pa0, pa1, pa2, pa3);
        }
        __syncthreads();
        if (j + 2 < NT) DMA_KV(buf, (j + 2) * KVBLK);
    }
    asm volatile("s_waitcnt vmcnt(0)" ::: "memory");
    __syncthreads();
#undef DMA_KV
}
__device__ __forceinline__ void normalize_o(f32x16 (&o)[4], float l_reg, ALAS float* ws, int r32, int hi) {
    if (hi == 0) ws[r32] = l_reg; asm volatile("s_waitcnt lgkmcnt(0)" ::: "memory");
#pragma unroll
    for (int r = 0; r < 16; ++r) { const float rl = __builtin_amdgcn_rcpf(ws[crow(r, hi)]);
#pragma unroll
        for (int d = 0; d < 4; ++d) o[d][r] *= rl; }
    asm volatile("s_waitcnt lgkmcnt(0)" ::: "memory");
}
__device__ __forceinline__ void row_sumsq(const f32x16 (&o)[4], ALAS float* scr, ALAS float* rowss, int lane, int r32, int hi) {
#pragma unroll
    for (int r = 0; r < 16; ++r) { float s = 0.f;
#pragma unroll
        for (int d = 0; d < 4; ++d) s += o[d][r] * o[d][r];
        scr[crow(r, hi) * 33 + r32] = s; }
    asm volatile("s_waitcnt lgkmcnt(0)" ::: "memory");
    float t = 0.f;
#pragma unroll
    for (int i = 0; i < 16; ++i) t += scr[r32 * 33 + hi * 16 + i];
    t += __shfl_xor(t, 32);
    if (hi == 0) rowss[r32] = t;
    asm volatile("s_waitcnt lgkmcnt(0)" ::: "memory");
}
__device__ __forceinline__ void store_rows_bf16(const f32x16 (&y)[4], ALAS bf16_t* stg, bf16_t* dst, int lane, int r32, int hi) {
#pragma unroll
    for (int r = 0; r < 16; ++r) { const int orow = crow(r, hi);
#pragma unroll
        for (int d0 = 0; d0 < 4; ++d0) stg[orow * 128 + d0 * 32 + r32] = f2bf(y[d0][r]); }
    asm volatile("s_waitcnt lgkmcnt(0)" ::: "memory");
#pragma unroll 1
    for (int i = 0; i < 8; ++i) { const int row = i * 4 + (lane >> 4), ch = lane & 15; const u32x4 v = *(const ALAS u32x4*)(stg + row * 128 + ch * 8); *(u32x4*)(dst + (size_t)row * D + ch * 8) = v; }
    asm volatile("s_waitcnt lgkmcnt(0)" ::: "memory");
}

struct AttnArgs { const bf16_t* PROJ; bf16_t* AO; float* ssna; float* scratch; const float* rpb; const float* gout; const float* lamp; const float* subg; const float* t5; };

__device__ __forceinline__ void da_unit(const AttnArgs& A, int u, ALAS char* lds) {
    const int tid = threadIdx.x, wid = __builtin_amdgcn_readfirstlane(tid >> 6), lane = tid & 63, r32 = lane & 31, hi = lane >> 5;
    const int b = u >> 6, h = (u >> 3) & 7, qb = u & 7;
    ALAS float* lut = (ALAS float*)(lds + L_LUT); ALAS float* misc = (ALAS float*)(lds + L_MISC);
    { const int rel = tid - 256; lut[tid] = A.t5[t5_bucket(rel) * NH + h] * LOG2E; }
    if (wid == 0) { float a = A.lamp[lane] * A.lamp[64 + lane], c = A.lamp[128 + lane] * A.lamp[192 + lane];
#pragma unroll
        for (int off = 1; off < 64; off <<= 1) { a += __shfl_xor(a, off); c += __shfl_xor(c, off); }
        if (lane == 0) misc[0] = __expf(a) - __expf(c) + LAM_INIT; }
    __syncthreads();
    const float lam = misc[0];
    const size_t tok0 = (size_t)b * SEQ + qb * 256, ktok0 = (size_t)b * SEQ;
    DaBias B; B.lut = lut; B.cneg = A.t5[15 * NH + h] * LOG2E; B.cpos = A.t5[31 * NH + h] * LOG2E; B.q0w = qb * 256 + wid * 32; B.lbase = 256 - B.q0w - r32 + 4 * hi;
    ALAS float* ws = (ALAS float*)(lds + L_WS) + wid * 64;
    f32x16 o[4]; float l_reg; int nt = SEQ / KVBLK; asm volatile("" : "+s"(nt));
    float* scr_g = A.scratch + ((size_t)u * NW + wid) * (64 * 64);
    attn_pass<64, DaBias, false>(A.PROJ + tok0 * PW + O_DAQ + h * HD, A.PROJ + ktok0 * PW + O_DAK + h * HD, A.PROJ + ktok0 * PW + O_DAV + h * HD, nt, B, lds, o, l_reg);
    int lane1 = lane; asm volatile("" : "+v"(lane1)); const int r32a = lane1 & 31, hia = lane1 >> 5;
    normalize_o(o, l_reg, ws, r32a, hia);
    { char* sp = (char*)scr_g; const unsigned so = (unsigned)lane1 * 16u;
#pragma unroll
      for (int i = 0; i < 16; ++i) { const int d = i >> 2, g = i & 3; *(f32x4*)(sp + so + i * 1024) = (f32x4){o[d][4 * g], o[d][4 * g + 1], o[d][4 * g + 2], o[d][4 * g + 3]}; } }
    attn_pass<64, DaBias, false>(A.PROJ + tok0 * PW + O_DAQ + h * HD + 64, A.PROJ + ktok0 * PW + O_DAK + h * HD + 64, A.PROJ + ktok0 * PW + O_DAV + h * HD, nt, B, lds, o, l_reg);
    int lane2 = lane; asm volatile("" : "+v"(lane2)); const int r32b = lane2 & 31, hib = lane2 >> 5;
    normalize_o(o, l_reg, ws, r32b, hib);
    asm volatile("s_waitcnt vmcnt(0)" ::: "memory");
    { unsigned long long spv = (unsigned long long)(uintptr_t)(A.scratch + ((size_t)u * NW + wid) * (64 * 64)); asm volatile("" : "+s"(spv));
      const char* sp = (const char*)(uintptr_t)spv; const unsigned so = (unsigned)lane2 * 16u;
#pragma unroll
      for (int i = 0; i < 16; ++i) { const int d = i >> 2, g = i & 3; const f32x4 v = *(const f32x4*)(sp + so + i * 1024);
          o[d][4 * g] = v[0] - lam * o[d][4 * g]; o[d][4 * g + 1] = v[1] - lam * o[d][4 * g + 1]; o[d][4 * g + 2] = v[2] - lam * o[d][4 * g + 2]; o[d][4 * g + 3] = v[3] - lam * o[d][4 * g + 3]; } }
    ALAS float* scr = (ALAS float*)(lds + L_V + wid * 8192);
    row_sumsq(o, scr, ws, lane2, r32b, hib);
    float gs[4];
#pragma unroll
    for (int d = 0; d < 4; ++d) gs[d] = A.subg[d * 32 + r32b] * (1.f - LAM_INIT);
#pragma unroll
    for (int r = 0; r < 16; ++r) { const float rstd = rsqrtf(ws[crow(r, hib)] * (1.f / HD) + EPS);
#pragma unroll
        for (int d = 0; d < 4; ++d) o[d][r] = o[d][r] * rstd * gs[d]; }
    asm volatile("s_waitcnt lgkmcnt(0)" ::: "memory");
    ALAS bf16_t* stg = (ALAS bf16_t*)(lds + L_V) + wid * (32 * 128);
    store_rows_bf16(o, stg, A.AO + (tok0 + wid * 32) * D + 1024 + h * HD, lane2, r32b, hib);
    __syncthreads();
}
__device__ __forceinline__ void na_unit(const AttnArgs& A, int u, ALAS char* lds) {
    const int tid = threadIdx.x, wid = __builtin_amdgcn_readfirstlane(tid >> 6), lane = tid & 63, r32 = lane & 31, hi = lane >> 5;
    const int b = u >> 6, h = (u >> 3) & 7, rblk = u & 7, r0 = rblk * 4;
    ALAS float* tab = (ALAS float*)(lds + L_LUT);
    for (int i = tid; i < 1024; i += NW * 64) tab[i] = 0.f;
    __syncthreads();
    if (tid < 15 * 32) { const int rr = tid >> 5, cc = tid & 31; if (cc < 31) tab[64 + rr * 32 + cc] = A.rpb[(h * 15 + rr) * 31 + cc] * LOG2E; }
    __syncthreads();
    const int bs = min(max(r0 - 4, 0), 24), be = min(max(r0 + 3 - 4, 0), 24) + 7; const int NT = be - bs + 1;
    const int rw = r0 + (wid >> 1), qc = 32 * (wid & 1) + r32, cs = min(max(qc - 8, 0), 48);
    NaBias B; B.tab = tab; B.bs = bs; B.rw = rw; B.rsw = min(max(rw - 4, 0), 24); B.lbase = 64 + 4 * hi - qc + 15;
    unsigned m0 = 0u, m1 = 0u;
#pragma unroll
    for (int r = 0; r < 16; ++r) { const int kc = crow(r, hi); if (kc >= cs && kc < cs + 16) m0 |= 1u << r; if (kc + 32 >= cs && kc + 32 < cs + 16) m1 |= 1u << r; }
    B.mask0 = m0; B.mask1 = m1;
    const size_t tok0 = (size_t)b * SEQ + r0 * 64, ktok0 = (size_t)b * SEQ + bs * 64;
    ALAS float* ws = (ALAS float*)(lds + L_WS) + wid * 64;
    f32x16 o[4]; float l_reg;
    na_pass(A.PROJ + tok0 * PW + O_NAQ + h * HD, A.PROJ + ktok0 * PW + O_NAK + h * HD, A.PROJ + ktok0 * PW + O_NAV + h * HD, NT, B, lds, o, l_reg);
    int lane2 = lane; asm volatile("" : "+v"(lane2)); const int r32b = lane2 & 31, hib = lane2 >> 5;
    normalize_o(o, l_reg, ws, r32b, hib);
    ALAS float* scr = (ALAS float*)(lds + L_V + wid * 8192);
    row_sumsq(o, scr, ws, lane2, r32b, hib);
    if (hib == 0) atomicAdd(A.ssna + tok0 + wid * 32 + r32b, ws[r32b]);
    float gs[4];
#pragma unroll
    for (int d = 0; d < 4; ++d) gs[d] = A.gout[h * HD + d * 32 + r32b];
#pragma unroll
    for (int r = 0; r < 16; ++r)
#pragma unroll
        for (int d = 0; d < 4; ++d) o[d][r] *= gs[d];
    ALAS bf16_t* stg = (ALAS bf16_t*)(lds + L_V) + wid * (32 * 128);
    store_rows_bf16(o, stg, A.AO + (tok0 + wid * 32) * D + h * HD, lane2, r32b, hib);
    __syncthreads();
}
#undef SBAR
}

static_assert(att::L_END <= LDSCTL_OFF && RING_BYTES <= LDSCTL_OFF, "LDS map");
struct Args { const float* in[17]; float* out; unsigned char* ws; int ph_lo, ph_hi, li, pad; };
enum { PH_0A = 0, PH_0B = 1, PH_1 = 2, PH_2 = 3, PH_3 = 4, PH_4 = 5, PH_5 = 6, PH_6 = 7, PH_N = 8 };
__global__ void __launch_bounds__(NWAVES * 64, 2) mega(Args args) {
    extern __shared__ __attribute__((aligned(16))) unsigned char lds[];
    Frame F;
    F.lds = (LAS unsigned char*)lds;
    F.MISC = (volatile LAS unsigned*)(F.lds + MISC_OFF);
    F.tid = threadIdx.x; F.lane = F.tid & 63; F.wave = __builtin_amdgcn_readfirstlane(F.tid >> 6);
    F.G = gridDim.x; { const int bx = blockIdx.x; F.vcu = (F.G % 8 == 0) ? (bx % 8) * (F.G / 8) + bx / 8 : bx; }
    unsigned char* ws = args.ws;
    F.ctl = (gu32*)(ws + WS_CTL);
    const float* x = args.in[0]; const float* c = args.in[1]; const float* w_ada = args.in[2]; const float* b_ada = args.in[3];
    const float* norm1_g = args.in[4]; const float* w_in = args.in[5]; const float* w_out = args.in[11];
    const float* norm2_g = args.in[12]; const float* w_gate = args.in[13]; const float* w_up = args.in[14]; const float* w_down = args.in[15]; const float* final_g = args.in[16];
    float* mod = (float*)(ws + CTL_MOD); float* ssna = (float*)(ws + CTL_SSNA); float* ss1 = (float*)(ws + CTL_SS1); float* ss2 = (float*)(ws + CTL_SS2);
    float* bgu = (float*)(ws + WS_BGU);
    bf16_t* Win_t = (bf16_t*)(ws + WS_WIN); bf16_t* Wout_t = (bf16_t*)(ws + WS_WOUT); bf16_t* Wgu_t = (bf16_t*)(ws + WS_WGU); bf16_t* Wd_t = (bf16_t*)(ws + WS_WD);
    bf16_t* H = (bf16_t*)(ws + WS_H); bf16_t* AO = H; bf16_t* PROJ = (bf16_t*)(ws + WS_PROJ); bf16_t* ACT = PROJ;
    float* X1 = (float*)(ws + WS_X1); bf16_t* A2 = (bf16_t*)(ws + WS_A2);
    for (int u = F.tid; u < (LDS_BYTES - LDSCTL_OFF) / 4; u += NWAVES * 64) ((LAS unsigned*)(F.lds + LDSCTL_OFF))[u] = 0u;
    __syncthreads();
    XcdBarrier bar = xcd_barrier_post((unsigned*)(F.ctl + CW_BAR) + args.li * XCD_BAR_WORDS, F.MISC + 8);
    const int lo = args.ph_lo, hi = args.ph_hi;
#define IN(k) (lo <= (k) && (k) < hi)
#define SEAM(k) do { if (IN(k) && IN((k) + 1)) xcd_barrier(bar); } while (0)
#ifndef PROBE_REP
#define PROBE_REP 0
#endif
#define NREP(k) (((PROBE_REP >> (k)) & 1) ? 2 : 1)
#define ACCP(k, rep, p) ((((PROBE_REP >> (k)) & 1) && (rep) == 0) ? (float*)(ws + CTL_DUMMY) : (p))

    if (IN(PH_0A)) for (int rep = 0; rep < NREP(PH_0A); ++rep) { P0Args a{c, w_ada, b_ada, w_in, w_out, w_gate, w_up, w_down, ACCP(PH_0A, rep, mod), Win_t, Wout_t, Wgu_t, Wd_t}; p0a_phase(F, a); __syncthreads(); }
    SEAM(PH_0A);
    if (IN(PH_0B)) for (int rep = 0; rep < NREP(PH_0B); ++rep) { p0b_phase(F, x, mod, norm1_g, H, Wgu_t, bgu); }
    SEAM(PH_0B);
    if (IN(PH_1)) for (int rep = 0; rep < NREP(PH_1); ++rep) {
        pg8::Gemm g{H, Win_t, M, PW, D}; pg8::StaticOrder S; S.init(M, PW, F.G, (int)blockIdx.x);
        pg8::EpiProj E{PROJ};
        pg8::gemm_phase<pg8::EpiProj, pg8::StaticOrder, true, true>(F.lds + RING_OFF, g, S, E);
    }
    SEAM(PH_1);
    if (IN(PH_2)) for (int rep = 0; rep < NREP(PH_2); ++rep) {
        att::AttnArgs A{PROJ, AO, ACCP(PH_2, rep, ssna), (float*)(ws + WS_A2), args.in[6], args.in[7], args.in[8], args.in[9], args.in[10]};
        for (int u = F.vcu; u < 256; u += F.G) att::da_unit(A, u, (LAS char*)F.lds);
        for (int u = F.vcu; u < 256; u += F.G) att::na_unit(A, u, (LAS char*)F.lds);
    }
    SEAM(PH_2);
    if (IN(PH_3)) for (int rep = 0; rep < NREP(PH_3); ++rep) {
        pg8::Gemm g{AO, Wout_t, M, D, D}; pg8::StaticOrder S; S.init(M, D, F.G, (int)blockIdx.x);
        pg8::EpiMix E{x, mod, norm2_g, ssna, X1, A2, ACCP(PH_3, rep, ss1)};
        pg8::gemm_phase<pg8::EpiMix, pg8::StaticOrder, true, true>(F.lds + RING_OFF, g, S, E);
    }
    SEAM(PH_3);
    if (IN(PH_4)) for (int rep = 0; rep < NREP(PH_4); ++rep) {
        pg8::Gemm g{A2, Wgu_t, M, 2 * DFF, D}; pg8::StaticOrder S; S.init(M, 2 * DFF, F.G, (int)blockIdx.x);
        pg8::EpiGU E{ss1, bgu, ACT};
        pg8::gemm_phase<pg8::EpiGU, pg8::StaticOrder, true, true>(F.lds + RING_OFF, g, S, E);
    }
    SEAM(PH_4);
    if (IN(PH_5)) for (int rep = 0; rep < NREP(PH_5); ++rep) {
        pg8::Gemm g{ACT, Wd_t, M, D, DFF}; pg8::StaticOrder S; S.init(M, D, F.G, (int)blockIdx.x);
        pg8::EpiDown E{X1, mod, args.out, ACCP(PH_5, rep, ss2)};
        pg8::gemm_phase<pg8::EpiDown, pg8::StaticOrder, true, true>(F.lds + RING_OFF, g, S, E);
    }
    SEAM(PH_5);
    if (IN(PH_6)) { p6_phase(F, args.out, ss2, final_g); }
#undef IN
#undef SEAM
}

extern "C" void kernel_launch(void* const* d_in, const int* in_sizes, int n_in, void* d_out, int out_size, void* d_ws, size_t ws_size, hipStream_t stream) {
    static int grid = 0;
    if (grid == 0) {
        if (n_in != 17 || out_size != M * D || ws_size < WS_END) { fprintf(stderr, "kernel_launch: unexpected shapes n_in %d out %d ws %zu\n", n_in, out_size, ws_size); grid = -1; return; }
        int dev = 0, cus = 0, per_cu = 0;
        if (hipGetDevice(&dev) != hipSuccess || hipDeviceGetAttribute(&cus, hipDeviceAttributeMultiprocessorCount, dev) != hipSuccess) { grid = -1; return; }
        if (hipFuncSetAttribute((const void*)mega, hipFuncAttributeMaxDynamicSharedMemorySize, LDS_BYTES) != hipSuccess) { fprintf(stderr, "kernel_launch: hipFuncSetAttribute failed\n"); grid = -1; return; }
        if (hipOccupancyMaxActiveBlocksPerMultiprocessor(&per_cu, (const void*)mega, NWAVES * 64, LDS_BYTES) != hipSuccess || per_cu < 1) { fprintf(stderr, "kernel_launch: occupancy query says %d\n", per_cu); per_cu = 1; }
        (void)hipGetLastError();
        grid = cus;
        if (grid != 256) fprintf(stderr, "kernel_launch: grid %d (expected 256)\n", grid);
    }
    if (grid < 0) return;
    char* ws = (char*)d_ws;
    (void)hipMemsetAsync(ws + WS_CTL, 0, CTL_BYTES, stream);
    Args a{};
    for (int i = 0; i < 17; ++i) a.in[i] = (const float*)d_in[i];
    a.out = (float*)d_out; a.ws = (unsigned char*)d_ws;
    a.ph_lo = PH_0A; a.ph_hi = PH_N; a.li = 0;
    hipLaunchKernelGGL(mega, dim3(grid), dim3(NWAVES * 64), LDS_BYTES, stream, a);
    const hipError_t le = hipPeekAtLastError();
    if (le != hipSuccess) fprintf(stderr, "kernel_launch: launch failed: %s\n", hipGetErrorName(le));
}
```
